# Optimizing an MI355X kernel written in HIP

```python
import math
import jax, jax.numpy as jnp
from jax import lax
import numpy as np

D_MODEL = 1024
BATCH = 4
SEQ = 4096
DEPTH = 2

CHUNK = 64
Q_BLOCK = 128
N_A_LAYERS = DEPTH // 2
N_B_LAYERS = DEPTH - N_A_LAYERS
HEAD_DIM = 64
FOX_HEADS = D_MODEL // HEAD_DIM
DIFF_HEADS = D_MODEL // (2 * HEAD_DIM)
DIFF_V_DIM = 2 * HEAD_DIM
D_FF = 2816
CONV_WIDTH = 3
ROPE_THETA = 10000.0
LN_EPS = 1e-5
RMS_EPS = 1e-5
DN_ALPHA = (2 * DEPTH) ** 0.25
DN_BETA = (8 * DEPTH) ** -0.25

kernel_name = 'yoco_fox_diffattn_convffn_deepnorm'


def _layer_norm(x, g, b):
    xf = x.astype(jnp.float32)
    mu = jnp.mean(xf, axis=-1, keepdims=True)
    var = jnp.mean(jnp.square(xf - mu), axis=-1, keepdims=True)
    y = (xf - mu) * lax.rsqrt(var + LN_EPS)
    return (y * g.astype(jnp.float32) + b.astype(jnp.float32)).astype(x.dtype)


def _rope_tables(seq_len):
    inv_freq = 1.0 / (ROPE_THETA ** (jnp.arange(0, HEAD_DIM, 2, dtype=jnp.float32) / HEAD_DIM))
    ang = jnp.arange(seq_len, dtype=jnp.float32)[:, None] * inv_freq[None, :]
    return jnp.cos(ang), jnp.sin(ang)


def _apply_rope(t, cos, sin):
    half = t.shape[-1] // 2
    t1, t2 = t[..., :half], t[..., half:]
    c = cos.astype(t.dtype)
    s = sin.astype(t.dtype)
    return jnp.concatenate([t1 * c - t2 * s, t2 * c + t1 * s], axis=-1)


def _heads(t, n_heads, d):
    b, s, _ = t.shape
    return t.reshape(b, s, n_heads, d).transpose(0, 2, 1, 3)


def _merge_blocks(o):
    nb, b, h, qb, dv = o.shape
    return o.transpose(1, 0, 3, 2, 4).reshape(b, nb * qb, h * dv)


def _fox_attention(x, w_in, b_f, w_out):
    b, s, d = x.shape
    proj = x @ w_in
    q = _heads(proj[..., :d], FOX_HEADS, HEAD_DIM)
    k = _heads(proj[..., d:2 * d], FOX_HEADS, HEAD_DIM)
    v = _heads(proj[..., 2 * d:3 * d], FOX_HEADS, HEAD_DIM)
    f_logit = proj[..., 3 * d:].astype(jnp.float32) + b_f.astype(jnp.float32)
    c = jnp.cumsum(jax.nn.log_sigmoid(f_logit), axis=1).transpose(0, 2, 1)
    scale = HEAD_DIM ** -0.5
    kpos = jnp.arange(s)

    def block(i):
        start = i * Q_BLOCK
        qb = lax.dynamic_slice_in_dim(q, start, Q_BLOCK, axis=2)
        cb = lax.dynamic_slice_in_dim(c, start, Q_BLOCK, axis=2)
        logits = jnp.einsum('bhqd,bhkd->bhqk', qb, k).astype(jnp.float32) * scale
        logits = logits + cb[..., :, None] - c[..., None, :]
        qpos = start + jnp.arange(Q_BLOCK)
        mask = kpos[None, :] <= qpos[:, None]
        p = jax.nn.softmax(jnp.where(mask, logits, -jnp.inf), axis=-1).astype(v.dtype)
        return jnp.einsum('bhqk,bhkd->bhqd', p, v)

    o = lax.map(block, jnp.arange(s // Q_BLOCK))
    return _merge_blocks(o) @ w_out


def _shared_kv(x, w_kv, cos, sin):
    b, s, _ = x.shape
    kw = 2 * DIFF_HEADS * HEAD_DIM
    proj = x @ w_kv
    k = proj[..., :kw].reshape(b, s, 2, DIFF_HEADS, HEAD_DIM).transpose(2, 0, 3, 1, 4)
    k1 = _apply_rope(k[0], cos, sin)
    k2 = _apply_rope(k[1], cos, sin)
    v = _heads(proj[..., kw:], DIFF_HEADS, DIFF_V_DIM)
    return k1, k2, v


def _diff_attention(x, k1, k2, v, w_q, lam_p, subln_g, w_out, lambda_init, cos, sin):
    b, s, _ = x.shape
    qp = (x @ w_q).reshape(b, s, 2, DIFF_HEADS, HEAD_DIM).transpose(2, 0, 3, 1, 4)
    q1 = _apply_rope(qp[0], cos, sin)
    q2 = _apply_rope(qp[1], cos, sin)
    lp = lam_p.astype(jnp.float32)
    lam = jnp.exp(jnp.sum(lp[0] * lp[1])) - jnp.exp(jnp.sum(lp[2] * lp[3])) + lambda_init
    scale = HEAD_DIM ** -0.5
    kpos = jnp.arange(s)

    def block(i):
        start = i * Q_BLOCK
        qb1 = lax.dynamic_slice_in_dim(q1, start, Q_BLOCK, axis=2)
        qb2 = lax.dynamic_slice_in_dim(q2, start, Q_BLOCK, axis=2)
        qpos = start + jnp.arange(Q_BLOCK)
        mask = kpos[None, :] < ((qpos // CHUNK) + 1)[:, None] * CHUNK
        s1 = jnp.einsum('bhqd,bhkd->bhqk', qb1, k1).astype(jnp.float32) * scale
        s2 = jnp.einsum('bhqd,bhkd->bhqk', qb2, k2).astype(jnp.float32) * scale
        p1 = jax.nn.softmax(jnp.where(mask, s1, -jnp.inf), axis=-1)
        p2 = jax.nn.softmax(jnp.where(mask, s2, -jnp.inf), axis=-1)
        a = (p1 - lam * p2).astype(v.dtype)
        return jnp.einsum('bhqk,bhkd->bhqd', a, v)

    o = lax.map(block, jnp.arange(s // Q_BLOCK)).astype(jnp.float32)
    o = o * lax.rsqrt(jnp.mean(jnp.square(o), axis=-1, keepdims=True) + RMS_EPS)
    o = (o * subln_g.astype(jnp.float32) * (1.0 - lambda_init)).astype(x.dtype)
    return _merge_blocks(o) @ w_out


def _conv_ffn(x, w_in, conv_w, conv_b, w_out):
    s = x.shape[1]
    u = x @ w_in
    up = jnp.pad(u, ((0, 0), (CONV_WIDTH - 1, 0), (0, 0)))
    u = sum(conv_w[j] * up[:, j:j + s] for j in range(CONV_WIDTH)) + conv_b
    g, val = u[..., :D_FF], u[..., D_FF:]
    return (jax.nn.silu(g) * val) @ w_out


def setup_inputs(seed: int = 0) -> dict:
    key = jax.random.key(seed)
    ks = jax.random.split(key, 20)
    d = D_MODEL
    f32 = jnp.float32
    nrm = lambda k, shape, sc: jax.random.normal(k, shape, f32) * sc
    return {
        'x': jax.random.normal(ks[0], (BATCH, SEQ, d), f32),
        'a_w_in': nrm(ks[1], (N_A_LAYERS, d, 3 * d + FOX_HEADS), d ** -0.5),
        'a_b_f': jax.random.uniform(ks[2], (N_A_LAYERS, FOX_HEADS), f32, 1.0, 6.0),
        'a_w_out': nrm(ks[3], (N_A_LAYERS, d, d), DN_BETA * d ** -0.5),
        'kv_w': nrm(ks[4], (d, 2 * DIFF_HEADS * HEAD_DIM + DIFF_HEADS * DIFF_V_DIM), d ** -0.5),
        'b_w_q': nrm(ks[5], (N_B_LAYERS, d, 2 * DIFF_HEADS * HEAD_DIM), d ** -0.5),
        'b_lambda': nrm(ks[6], (N_B_LAYERS, 4, HEAD_DIM), 0.1),
        'b_subln_g': 1.0 + nrm(ks[7], (N_B_LAYERS, DIFF_V_DIM), 0.02),
        'b_w_out': nrm(ks[8], (N_B_LAYERS, DIFF_HEADS * DIFF_V_DIM, d), DN_BETA * d ** -0.5),
        'ffn_w_in': nrm(ks[9], (DEPTH, d, 2 * D_FF), d ** -0.5),
        'ffn_conv_w': nrm(ks[10], (DEPTH, CONV_WIDTH, 2 * D_FF), CONV_WIDTH ** -0.5),
        'ffn_conv_b': nrm(ks[11], (DEPTH, 2 * D_FF), 0.02),
        'ffn_w_out': nrm(ks[12], (DEPTH, D_FF, d), DN_BETA * D_FF ** -0.5),
        'ln_attn_g': 1.0 + nrm(ks[13], (DEPTH, d), 0.02),
        'ln_attn_b': nrm(ks[14], (DEPTH, d), 0.02),
        'ln_ffn_g': 1.0 + nrm(ks[15], (DEPTH, d), 0.02),
        'ln_ffn_b': nrm(ks[16], (DEPTH, d), 0.02),
    }


def reference(x, a_w_in, a_b_f, a_w_out, kv_w, b_w_q, b_lambda, b_subln_g, b_w_out,
              ffn_w_in, ffn_conv_w, ffn_conv_b, ffn_w_out,
              ln_attn_g, ln_attn_b, ln_ffn_g, ln_ffn_b):
    cos, sin = _rope_tables(x.shape[1])
    k1 = k2 = v = None
    for layer in range(DEPTH):
        if layer < N_A_LAYERS:
            h = _fox_attention(x, a_w_in[layer], a_b_f[layer], a_w_out[layer])
        else:
            j = layer - N_A_LAYERS
            lambda_init = 0.8 - 0.6 * math.exp(-0.3 * layer)
            h = _diff_attention(x, k1, k2, v, b_w_q[j], b_lambda[j], b_subln_g[j], b_w_out[j],
                                lambda_init, cos, sin)
        x = _layer_norm(DN_ALPHA * x + h, ln_attn_g[layer], ln_attn_b[layer])
        f = _conv_ffn(x, ffn_w_in[layer], ffn_conv_w[layer], ffn_conv_b[layer], ffn_w_out[layer])
        x = _layer_norm(DN_ALPHA * x + f, ln_ffn_g[layer], ln_ffn_b[layer])
        if layer == N_A_LAYERS - 1:
            k1, k2, v = _shared_kv(x, kv_w, cos, sin)
    return x
```

```cpp
#include <hip/hip_runtime.h>
#include <hip/hip_bf16.h>
#include <cstdio>
#include <cstdint>
#include <cmath>
namespace pg8 {
#define PG8_LAS __attribute__((address_space(3)))
typedef unsigned short bf16_t;
typedef short bf16x8 __attribute__((ext_vector_type(8)));
typedef float f32x4 __attribute__((ext_vector_type(4)));
typedef unsigned u32x4 __attribute__((ext_vector_type(4)));
constexpr int BM = 256, BK = 64, HALF = 128, HTB = HALF * BK * 2  , STAGE_BYTES = 8 * HTB, NXCD = 8, WGM = 8;

__host__ __device__ __forceinline__ int lds_byte(int r, int c) { const int st = (r >> 4) * 2 + (c >> 5), rr = r & 15, cc = c & 31, ob = rr * 64 + cc * 2; return st * 1024 + (ob ^ (((ob >> 9) & 1) << 5)); }
__host__ __device__ __forceinline__ void stage_rc(int b, int& R, int& C) { const int st = b / 1024, sb = b % 1024, swz = sb ^ (((sb >> 9) & 1) << 5); R = (st >> 1) * 16 + swz / 64; C = (st & 1) * 32 + (swz % 64) / 2; }
__host__ __device__ __forceinline__ int perm32(int rho) { const int n = rho >> 4, i = rho & 15; return 8 * (i >> 2) + 4 * n + (i & 3); }

struct Unit { int pm, pn; };
struct Gemm { const bf16_t* A; const bf16_t* Bt; int M, N, K; };

struct StaticOrder {
    int nM, nN, nwg, G, c;
    __host__ __device__ void init(int M, int N, int G_, int c_) { nM = M / BM; nN = N / BM; nwg = nM * nN; G = G_; c = c_; }
    __host__ __device__ bool next(int i, Unit& u) const {
        const long L = (long)i * G + c; if (L >= nwg) return false;
        int wgid = (int)L; { const int q = nwg / NXCD, r = nwg % NXCD, xcd = wgid % NXCD, off = wgid / NXCD; wgid = (xcd < r ? xcd * (q + 1) : r * (q + 1) + (xcd - r) * q) + off; }
        const int nig = WGM * nN, gid = wgid / nig, fm = gid * WGM, gsz = (nM - fm) < WGM ? (nM - fm) : WGM;
        u.pm = fm + ((wgid % nig) % gsz); u.pn = (wgid % nig) / gsz; return true;
    }
    __device__ __forceinline__ void a_ready(const Unit&) const {}
    __device__ __forceinline__ void done(const Unit&) const {}
};

__device__ __forceinline__ unsigned cvt_pk_bf16(float lo, float hi) { unsigned r; asm volatile("v_cvt_pk_bf16_f32 %0, %1, %2" : "=v"(r) : "v"(lo), "v"(hi)); return r; }
typedef float f32x2 __attribute__((ext_vector_type(2)));
__device__ __forceinline__ f32x2 gelu_pk(f32x2 v) {
    const f32x2 av = __builtin_elementwise_abs(v), d = av * 0.2316418882f + 1.0f;
    f32x2 t; t.x = __builtin_amdgcn_rcpf(d.x); t.y = __builtin_amdgcn_rcpf(d.y);
    f32x2 q = t * 0.5307027145f + (-0.7265760135f); q = q * t + 0.7107068705f; q = q * t + (-0.142248368f); q = q * t + 0.127414796f; q = q * t;
    const f32x2 s = (v * v) * (-0.72134752044f);
    f32x2 e; e.x = __builtin_amdgcn_exp2f(s.x); e.y = __builtin_amdgcn_exp2f(s.y);
    const f32x2 m = v * (q * e), r = v - m;
    f32x2 o; o.x = v.x < 0.f ? m.x : r.x; o.y = v.y < 0.f ? m.y : r.y; return o;
}

template <int ACT  > struct EpiBf16 {
    static constexpr bool PERM = true, AFTER_DRAIN = false; static_assert(ACT == 0 || ACT == 1, "EpiBf16: ACT is 0 (none) or 1 (gelu_pk)");
    bf16_t* O; int ldc; const float* bias; int split_cols; size_t split_stride; float scale0;
    __device__ __forceinline__ void operator()(const f32x4 (&acc)[2][2][4][2], const Unit& u, int wr, int wc, int fr, int fq) const {
        const int row0 = u.pm * BM + wr * 64 + fr; int colt = u.pn * BM; bf16_t* base = O;
        float sc = 1.f; if (split_cols) { const int t = colt / split_cols; base += (size_t)t * split_stride; colt -= t * split_cols; if (t == 0) sc = scale0; }
        const int col0 = colt + wc * 32 + 8 * fq, bcol0 = u.pn * BM + wc * 32 + 8 * fq;
        f32x4 bv[2][2];
#pragma unroll
        for (int bj = 0; bj < 2; ++bj)
#pragma unroll
            for (int n = 0; n < 2; ++n) bv[bj][n] = bias ? *(const f32x4*)(bias + bcol0 + bj * HALF + 4 * n) : (f32x4){0.f, 0.f, 0.f, 0.f};
#pragma unroll
        for (int ai = 0; ai < 2; ++ai)
#pragma unroll
            for (int m = 0; m < 4; ++m) { bf16_t* rowp = base + (size_t)(row0 + ai * HALF + m * 16) * ldc + col0;
#pragma unroll
                for (int bj = 0; bj < 2; ++bj) { f32x4 v0 = acc[ai][bj][m][0] + bv[bj][0], v1 = acc[ai][bj][m][1] + bv[bj][1];
                    if (ACT == 1) { f32x2 a = gelu_pk((f32x2){v0[0], v0[1]}), b = gelu_pk((f32x2){v0[2], v0[3]}), c = gelu_pk((f32x2){v1[0], v1[1]}), d = gelu_pk((f32x2){v1[2], v1[3]});
                        v0 = (f32x4){a.x, a.y, b.x, b.y}; v1 = (f32x4){c.x, c.y, d.x, d.y}; }
                    v0 = v0 * sc; v1 = v1 * sc; u32x4 w; w.x = cvt_pk_bf16(v0[0], v0[1]); w.y = cvt_pk_bf16(v0[2], v0[3]); w.z = cvt_pk_bf16(v1[0], v1[1]); w.w = cvt_pk_bf16(v1[2], v1[3]);
                    *(u32x4*)(rowp + bj * HALF) = w; } }
    }
};

struct PanelStats {
    unsigned* xbuf;
    unsigned* cnt;
    unsigned* tmo;
    int ntn; float eps;
    unsigned code;
    __device__ __forceinline__ bool run(const f32x4 (&v)[2][2][4][2], const Unit& u, int wr, int wc, int fr, int fq, PG8_LAS unsigned char* lds, int wid, int lane) const {
        typedef float f32x2v __attribute__((ext_vector_type(2)));
        PG8_LAS f32x2v* P = (PG8_LAS f32x2v*)lds;
        PG8_LAS f32x2v* S = (PG8_LAS f32x2v*)(lds + 8192);
        PG8_LAS unsigned* flag = (PG8_LAS unsigned*)(lds + 8192 + 2048);
#pragma unroll
        for (int ai = 0; ai < 2; ++ai)
#pragma unroll
            for (int m = 0; m < 4; ++m) {
                float s = 0.f;
#pragma unroll
                for (int bj = 0; bj < 2; ++bj)
#pragma unroll
                    for (int n = 0; n < 2; ++n) { const f32x4 x = v[ai][bj][m][n]; s += (x[0] + x[1]) + (x[2] + x[3]); }
                s += __shfl_xor(s, 16); s += __shfl_xor(s, 32);
                const float mw = s * (1.0f / 64.0f); float q = 0.f;
#pragma unroll
                for (int bj = 0; bj < 2; ++bj)
#pragma unroll
                    for (int n = 0; n < 2; ++n) { const f32x4 d = v[ai][bj][m][n] - mw; q += (d[0] * d[0] + d[1] * d[1]) + (d[2] * d[2] + d[3] * d[3]); }
                q += __shfl_xor(q, 16); q += __shfl_xor(q, 32);
                if (fq == 0) P[(ai * HALF + wr * 64 + m * 16 + fr) * 4 + wc] = (f32x2v){mw, q};
            }
        asm volatile("s_waitcnt lgkmcnt(0)" ::: "memory"); __builtin_amdgcn_s_barrier(); asm volatile("" ::: "memory");
#if defined(BROKEN_EXCHANGE_NO_WAIT)
#warning BROKEN CONTROL BUILD: the row-statistics exchange does not wait; results are wrong by design
        if (blockIdx.x >= 64) { const long long t0_ = clock64(); while (clock64() - t0_ < 60000) __builtin_amdgcn_s_sleep(8); }
#endif
        const int row = wid * 32 + (lane & 31);
        if (lane < 32) {
            const f32x2v a = P[row * 4 + 0], b = P[row * 4 + 1], c = P[row * 4 + 2], d = P[row * 4 + 3];
            const float mt = (a.x + b.x + c.x + d.x) * 0.25f;
            const float da = a.x - mt, db = b.x - mt, dc = c.x - mt, dd = d.x - mt;
            const float m2 = (a.y + b.y) + (c.y + d.y) + 64.0f * ((da * da + db * db) + (dc * dc + dd * dd));
            unsigned long long* slot = (unsigned long long*)xbuf + ((size_t)(u.pm * BM + row) * 4 + u.pn);
            __hip_atomic_store(slot, ((unsigned long long)__float_as_uint(m2) << 32) | __float_as_uint(mt), __ATOMIC_RELAXED, __HIP_MEMORY_SCOPE_AGENT);
        }
        asm volatile("s_waitcnt vmcnt(0)" ::: "memory");
        if (lane == 0) __hip_atomic_fetch_add(cnt + 64 * u.pm, 1u, __ATOMIC_RELAXED, __HIP_MEMORY_SCOPE_AGENT);
        if (wid == 0) {
            bool dead = false; const unsigned long long t0 = __builtin_amdgcn_s_memrealtime(); const unsigned want = 8u * (unsigned)ntn;
            for (;;) {
#if defined(BROKEN_EXCHANGE_NO_WAIT)
                break;
#endif
                if ((unsigned)__builtin_amdgcn_readfirstlane(__hip_atomic_load(cnt + 64 * u.pm, __ATOMIC_RELAXED, __HIP_MEMORY_SCOPE_AGENT)) >= want) break;
                if (__builtin_amdgcn_s_memrealtime() - t0 > 2000000ull) {
                    if (lane == 0) { unsigned expect = 0u; __hip_atomic_compare_exchange_strong(tmo + 1, &expect, code | (unsigned)(u.pm & 0xff), __ATOMIC_RELAXED, __ATOMIC_RELAXED, __HIP_MEMORY_SCOPE_AGENT);
                                     __hip_atomic_store(tmo, 1u, __ATOMIC_RELAXED, __HIP_MEMORY_SCOPE_AGENT); }
                    dead = true; break; }
                __builtin_amdgcn_s_sleep(2);
            }
            __builtin_amdgcn_fence(__ATOMIC_ACQUIRE, "agent");
            if (lane == 0) flag[0] = dead ? 1u : 0u;
        }
        asm volatile("s_waitcnt vmcnt(0) lgkmcnt(0)" ::: "memory"); __builtin_amdgcn_s_barrier(); asm volatile("" ::: "memory");
        const bool bad = flag[0] != 0u;
        if (lane < 32) {
            const unsigned long long* slot = (const unsigned long long*)xbuf + (size_t)(u.pm * BM + row) * 4; float mt[4], m2[4]; float ms = 0.f;
#pragma unroll
            for (int t = 0; t < 4; ++t) { if (t < ntn) { const unsigned long long w = __hip_atomic_load(slot + t, __ATOMIC_RELAXED, __HIP_MEMORY_SCOPE_AGENT); mt[t] = __uint_as_float((unsigned)w); m2[t] = __uint_as_float((unsigned)(w >> 32)); } else { mt[t] = 0.f; m2[t] = 0.f; } ms += mt[t]; }
            const float mean = ms / (float)ntn; float q = 0.f;
#pragma unroll
            for (int t = 0; t < 4; ++t) if (t < ntn) { const float dm = mt[t] - mean; q += m2[t] + 256.0f * dm * dm; }
            S[row] = (f32x2v){mean, 1.0f / sqrtf(q / (256.0f * (float)ntn) + eps)};
        }
        asm volatile("s_waitcnt lgkmcnt(0)" ::: "memory"); __builtin_amdgcn_s_barrier(); asm volatile("" ::: "memory");
        return bad;
    }
};
struct EpiLnRes {
    static constexpr bool PERM = false, AFTER_DRAIN = true;
    const float* base; float* out; int ldc; const float* bias; PanelStats st; unsigned poison;
    __device__ __forceinline__ void fused(f32x4 (&acc)[2][2][4][2], const Unit& u, int wr, int wc, int fr, int fq, PG8_LAS unsigned char* lds, int wid, int lane) const {
        typedef float f32x2v __attribute__((ext_vector_type(2)));
        const PG8_LAS f32x2v* S = (const PG8_LAS f32x2v*)(lds + 8192);
        const int col0 = u.pn * BM + wc * 32 + 4 * fq;
#pragma unroll
        for (int bj = 0; bj < 2; ++bj)
#pragma unroll
            for (int n = 0; n < 2; ++n) { const f32x4 bv = bias ? *(const f32x4*)(bias + col0 + bj * HALF + n * 16) : (f32x4){0.f, 0.f, 0.f, 0.f};
#pragma unroll
                for (int ai = 0; ai < 2; ++ai)
#pragma unroll
                    for (int m = 0; m < 4; ++m) acc[ai][bj][m][n] += bv; }
        f32x4 pre[4][2][2];
#pragma unroll
        for (int m = 0; m < 4; ++m) { const size_t off = (size_t)(u.pm * BM + wr * 64 + m * 16 + fr) * ldc + col0;
#pragma unroll
            for (int bj = 0; bj < 2; ++bj)
#pragma unroll
                for (int n = 0; n < 2; ++n) pre[m][bj][n] = *(const f32x4*)(base + off + bj * HALF + n * 16); }
        const bool bad = st.run(acc, u, wr, wc, fr, fq, lds, wid, lane) || poison != 0u;
        const float qnan = __builtin_nanf("");
#pragma unroll
        for (int ai = 0; ai < 2; ++ai)
#pragma unroll
            for (int m = 0; m < 4; ++m) { const int r = ai * HALF + wr * 64 + m * 16 + fr; const f32x2v sr = S[r]; const size_t off = (size_t)(u.pm * BM + r) * ldc + col0;
#pragma unroll
                for (int bj = 0; bj < 2; ++bj)
#pragma unroll
                    for (int n = 0; n < 2; ++n) { const f32x4 bs = ai == 0 ? pre[m][bj][n] : *(const f32x4*)(base + off + bj * HALF + n * 16); f32x4 o = bs + (acc[ai][bj][m][n] - sr.x) * sr.y;
                        if (bad) o = (f32x4){qnan, qnan, qnan, qnan}; *(f32x4*)(out + off + bj * HALF + n * 16) = o; }
                if (m & 1) asm volatile("" ::: "memory"); }
    }
};
struct EpiLnResLn {
    static constexpr bool PERM = false, AFTER_DRAIN = true;
    const float* base; float* out; bf16_t* xn; int ldc; const float* bias; PanelStats st1, st2; unsigned poison;
    __device__ __forceinline__ void fused(f32x4 (&acc)[2][2][4][2], const Unit& u, int wr, int wc, int fr, int fq, PG8_LAS unsigned char* lds, int wid, int lane) const {
        typedef float f32x2v __attribute__((ext_vector_type(2))); typedef unsigned u32x2v __attribute__((ext_vector_type(2)));
        const PG8_LAS f32x2v* S = (const PG8_LAS f32x2v*)(lds + 8192);
        const int col0 = u.pn * BM + wc * 32 + 4 * fq;
#pragma unroll
        for (int bj = 0; bj < 2; ++bj)
#pragma unroll
            for (int n = 0; n < 2; ++n) { const f32x4 bv = bias ? *(const f32x4*)(bias + col0 + bj * HALF + n * 16) : (f32x4){0.f, 0.f, 0.f, 0.f};
#pragma unroll
                for (int ai = 0; ai < 2; ++ai)
#pragma unroll
                    for (int m = 0; m < 4; ++m) acc[ai][bj][m][n] += bv; }
        bool bad = st1.run(acc, u, wr, wc, fr, fq, lds, wid, lane) || poison != 0u;
        const float qnan = __builtin_nanf("");
#pragma unroll
        for (int ai = 0; ai < 2; ++ai)
#pragma unroll
            for (int m = 0; m < 4; ++m) { const int r = ai * HALF + wr * 64 + m * 16 + fr; const f32x2v sr = S[r]; const size_t off = (size_t)(u.pm * BM + r) * ldc + col0;
#pragma unroll
                for (int bj = 0; bj < 2; ++bj)
#pragma unroll
                    for (int n = 0; n < 2; ++n) { const f32x4 bs = *(const f32x4*)(base + off + bj * HALF + n * 16); acc[ai][bj][m][n] = bs + (acc[ai][bj][m][n] - sr.x) * sr.y; }
                asm volatile("" : "+v"(acc[ai][0][m][0]), "+v"(acc[ai][0][m][1]), "+v"(acc[ai][1][m][0]), "+v"(acc[ai][1][m][1]));
                if (m & 1) asm volatile("" ::: "memory"); }
        const bool bad1 = bad;
        bad = st2.run(acc, u, wr, wc, fr, fq, lds, wid, lane) || bad;
#pragma unroll
        for (int ai = 0; ai < 2; ++ai)
#pragma unroll
            for (int m = 0; m < 4; ++m) { const int r = ai * HALF + wr * 64 + m * 16 + fr; const f32x2v sr = S[r]; const size_t off = (size_t)(u.pm * BM + r) * ldc + col0;
#pragma unroll
                for (int bj = 0; bj < 2; ++bj)
#pragma unroll
                    for (int n = 0; n < 2; ++n) { const f32x4 x1 = acc[ai][bj][m][n]; *(f32x4*)(out + off + bj * HALF + n * 16) = bad1 ? (f32x4){qnan, qnan, qnan, qnan} : x1;
                        const f32x4 o = (x1 - sr.x) * sr.y; u32x2v w; w.x = cvt_pk_bf16(o[0], o[1]); w.y = cvt_pk_bf16(o[2], o[3]);
                        if (bad) { w.x = 0x7fc07fc0u; w.y = 0x7fc07fc0u; } *(u32x2v*)(xn + off + bj * HALF + n * 16) = w; }
                asm volatile("" ::: "memory"); }
    }
};

template <class Epi, class Sched, bool ALIGN_EPI = false, bool SP2 = false>
__device__ __forceinline__ void gemm_phase(PG8_LAS unsigned char* lds, const Gemm g, const Sched& S, const Epi& E) {
    int tid_ = threadIdx.x; asm volatile("" : "+v"(tid_));
    const int tid = tid_, wid = __builtin_amdgcn_readfirstlane(tid >> 6), lane = tid & 63, wr = wid >> 2, wc = wid & 3, fr = lane & 15, fq = lane >> 4;
    const int K = g.K, nt = K / BK;
    unsigned voffA[2], voffB[2];
#pragma unroll
    for (int i = 0; i < 2; ++i) { int R, C; stage_rc(tid * 16 + i * 8192, R, C); const int Rb = Epi::PERM ? ((R & ~31) + perm32(R & 31)) : R;
        voffA[i] = (unsigned)(R * K + C) * 2u; voffB[i] = (unsigned)(Rb * K + C) * 2u; }
    const size_t kstep = (size_t)(BK * 2);
    const size_t hstep = (size_t)HALF * K * 2;
    const size_t tstep = 2 * hstep;
    const unsigned ldsw = (unsigned)wid * 1024u;
    const int aoff = lds_byte(wr * 64 + fr, fq * 8), boff = lds_byte(wc * 32 + fr, fq * 8);
#define PG8_SA(b, h) (((b) * 2 + (h)) * HTB)
#define PG8_SB(b, h) ((4 + (b) * 2 + (h)) * HTB)
#define PG8_STAGE(bufoff, gbase, voff) do { _Pragma("unroll") for (int _i = 0; _i < 2; ++_i) \
        __builtin_amdgcn_global_load_lds((const unsigned*)((const char*)(gbase) + (voff)[_i]), (PG8_LAS unsigned*)(lds + (bufoff) + ldsw + _i * 8192), 16, 0, 0); } while (0)
#define PG8_LDA(dst, b, h) do { _Pragma("unroll") for (int m = 0; m < 4; ++m) _Pragma("unroll") for (int k = 0; k < 2; ++k) dst[m][k] = *(const PG8_LAS bf16x8*)(lds + PG8_SA(b, h) + aoff + m * 2048 + k * 1024); } while (0)
#define PG8_LDB(dst, b, h) do { _Pragma("unroll") for (int n = 0; n < 2; ++n) _Pragma("unroll") for (int k = 0; k < 2; ++k) dst[n][k] = *(const PG8_LAS bf16x8*)(lds + PG8_SB(b, h) + boff + n * 2048 + k * 1024); } while (0)
#define PG8_MMA(ai, bj, At, Bt) do { __builtin_amdgcn_s_setprio(1); _Pragma("unroll") for (int m = 0; m < 4; ++m) _Pragma("unroll") for (int n = 0; n < 2; ++n) _Pragma("unroll") for (int k = 0; k < 2; ++k) \
        acc[ai][bj][m][n] = __builtin_amdgcn_mfma_f32_16x16x32_bf16(Bt[n][k], At[m][k], acc[ai][bj][m][n], 0, 0, 0); __builtin_amdgcn_s_setprio(0); } while (0)
#define PG8_WAIT_V(n) asm volatile("s_waitcnt vmcnt(" #n ")" ::: "memory")
#define PG8_WAIT_L(n) asm volatile("s_waitcnt lgkmcnt(" #n ")" ::: "memory")
#define PG8_BAR __builtin_amdgcn_s_barrier()
#define PG8_SCHED __builtin_amdgcn_sched_barrier(0)
    Unit cur, nxt; int ui = 0;
    if (!S.next(0, cur)) return;
    f32x4 acc[2][2][4][2];
#pragma unroll
    for (int a = 0; a < 2; ++a)
#pragma unroll
        for (int b = 0; b < 2; ++b)
#pragma unroll
            for (int m = 0; m < 4; ++m)
#pragma unroll
                for (int n = 0; n < 2; ++n) acc[a][b][m][n] = (f32x4){0.f, 0.f, 0.f, 0.f};
    bf16x8 At[4][2], B0[2][2], B1[2][2];
    const char* cA = (const char*)g.A + (size_t)cur.pm * tstep; const char* cB = (const char*)g.Bt + (size_t)cur.pn * tstep;
    S.a_ready(cur);
    if constexpr (SP2) {
        PG8_STAGE(PG8_SB(0, 0), cB, voffB); PG8_STAGE(PG8_SB(0, 1), cB + hstep, voffB); PG8_STAGE(PG8_SA(0, 0), cA, voffA); PG8_STAGE(PG8_SA(0, 1), cA + hstep, voffA);
        if (wr == 1) PG8_BAR;
        PG8_WAIT_V(2); PG8_BAR;
        PG8_STAGE(PG8_SB(1, 0), cB + kstep, voffB); PG8_STAGE(PG8_SA(1, 0), cA + kstep, voffA); PG8_STAGE(PG8_SB(1, 1), cB + hstep + kstep, voffB);
        PG8_WAIT_V(6); PG8_BAR;
    } else {
        PG8_STAGE(PG8_SB(0, 0), cB, voffB); PG8_STAGE(PG8_SA(0, 0), cA, voffA); PG8_STAGE(PG8_SB(0, 1), cB + hstep, voffB); PG8_STAGE(PG8_SA(0, 1), cA + hstep, voffA);
        if (wr == 1) PG8_BAR;
        PG8_WAIT_V(4); PG8_BAR;
        PG8_STAGE(PG8_SB(1, 0), cB + kstep, voffB); PG8_STAGE(PG8_SA(1, 0), cA + kstep, voffA); PG8_STAGE(PG8_SB(1, 1), cB + hstep + kstep, voffB);
        PG8_WAIT_V(6); PG8_BAR;
    }
    for (;;) {
        const bool has_next = S.next(ui + 1, nxt);
        const char* nA = has_next ? (const char*)g.A + (size_t)nxt.pm * tstep : cA; const char* nB = has_next ? (const char*)g.Bt + (size_t)nxt.pn * tstep : cB;
        for (int t = 0; t < nt; t += 2) {
            const bool last = (t == nt - 2);
            const char* a1 = cA + (size_t)(t + 1) * kstep;
            const char* a2 = last ? nA : cA + (size_t)(t + 2) * kstep; const char* b2 = last ? nB : cB + (size_t)(t + 2) * kstep;
            const char* a3 = a2 + kstep; const char* b3 = b2 + kstep;
            if (last && has_next) S.a_ready(nxt);
            if constexpr (SP2) {
            PG8_LDB(B0, 0, 0); PG8_LDB(B1, 0, 1); PG8_SCHED; PG8_LDA(At, 0, 0); PG8_STAGE(PG8_SA(1, 1), a1 + hstep, voffA);
            PG8_WAIT_V(8); PG8_WAIT_L(0); PG8_BAR; PG8_MMA(0, 0, At, B0); PG8_MMA(0, 1, At, B1); PG8_BAR; PG8_SCHED;
            PG8_LDA(At, 0, 1); PG8_STAGE(PG8_SB(0, 0), b2, voffB); PG8_STAGE(PG8_SB(0, 1), b2 + hstep, voffB); PG8_STAGE(PG8_SA(0, 0), a2, voffA);
            PG8_WAIT_V(8); PG8_WAIT_L(0); PG8_BAR; PG8_MMA(1, 0, At, B0); PG8_MMA(1, 1, At, B1); PG8_BAR; PG8_SCHED;
            PG8_LDB(B0, 1, 0); PG8_LDB(B1, 1, 1); PG8_SCHED; PG8_LDA(At, 1, 0); PG8_STAGE(PG8_SA(0, 1), a2 + hstep, voffA);
            PG8_WAIT_V(8); PG8_WAIT_L(0); PG8_BAR; PG8_MMA(0, 0, At, B0); PG8_MMA(0, 1, At, B1); PG8_BAR; PG8_SCHED;
            PG8_LDA(At, 1, 1); PG8_STAGE(PG8_SB(1, 0), b3, voffB); PG8_STAGE(PG8_SB(1, 1), b3 + hstep, voffB); PG8_STAGE(PG8_SA(1, 0), a3, voffA);
            PG8_WAIT_V(8); PG8_WAIT_L(0); PG8_BAR; PG8_MMA(1, 0, At, B0); PG8_MMA(1, 1, At, B1); PG8_BAR; PG8_SCHED;
            } else {
            PG8_LDB(B0, 0, 0); PG8_SCHED; PG8_LDA(At, 0, 0); PG8_STAGE(PG8_SA(1, 1), a1 + hstep, voffA);
            PG8_WAIT_L(8); PG8_BAR; PG8_WAIT_L(0); PG8_MMA(0, 0, At, B0); PG8_BAR; PG8_SCHED;
            PG8_LDB(B1, 0, 1); PG8_STAGE(PG8_SB(0, 0), b2, voffB);
            PG8_BAR; PG8_WAIT_L(0); PG8_MMA(0, 1, At, B1); PG8_BAR;
            PG8_LDA(At, 0, 1); PG8_STAGE(PG8_SA(0, 0), a2, voffA);
            PG8_BAR; PG8_WAIT_L(0); PG8_MMA(1, 0, At, B0); PG8_BAR; PG8_SCHED;
            PG8_STAGE(PG8_SB(0, 1), b2 + hstep, voffB);
            PG8_WAIT_V(6); PG8_BAR; PG8_MMA(1, 1, At, B1); PG8_BAR;
            PG8_LDB(B0, 1, 0); PG8_SCHED; PG8_LDA(At, 1, 0); PG8_STAGE(PG8_SA(0, 1), a2 + hstep, voffA);
            PG8_WAIT_L(8); PG8_BAR; PG8_WAIT_L(0); PG8_MMA(0, 0, At, B0); PG8_BAR; PG8_SCHED;
            PG8_LDB(B1, 1, 1); PG8_STAGE(PG8_SB(1, 0), b3, voffB);
            PG8_BAR; PG8_WAIT_L(0); PG8_MMA(0, 1, At, B1); PG8_BAR;
            PG8_LDA(At, 1, 1); PG8_STAGE(PG8_SA(1, 0), a3, voffA);
            PG8_BAR; PG8_WAIT_L(0); PG8_MMA(1, 0, At, B0); PG8_BAR; PG8_SCHED;
            PG8_STAGE(PG8_SB(1, 1), b3 + hstep, voffB);
            PG8_WAIT_V(6); PG8_BAR; PG8_MMA(1, 1, At, B1); PG8_BAR;
            }
        }
        if constexpr (ALIGN_EPI) { if (wr == 0) PG8_BAR; }
        if constexpr (!Epi::AFTER_DRAIN) { E(acc, cur, wr, wc, fr, fq); S.done(cur); }
        if (!has_next) break;
#pragma unroll
        for (int a = 0; a < 2; ++a)
#pragma unroll
            for (int b = 0; b < 2; ++b)
#pragma unroll
                for (int m = 0; m < 4; ++m)
#pragma unroll
                    for (int n = 0; n < 2; ++n) acc[a][b][m][n] = (f32x4){0.f, 0.f, 0.f, 0.f};
        cur = nxt; cA = nA; cB = nB; ++ui;
        if constexpr (ALIGN_EPI) { if (wr == 1) PG8_BAR; }
    }
    PG8_WAIT_V(0);
    if constexpr (!ALIGN_EPI) { if (wr == 0) PG8_BAR; }
    PG8_BAR;
    if constexpr (Epi::AFTER_DRAIN) { E.fused(acc, cur, wr, wc, fr, fq, lds, wid, lane); S.done(cur); }
#undef PG8_SA
#undef PG8_SB
#undef PG8_STAGE
#undef PG8_LDA
#undef PG8_LDB
#undef PG8_MMA
#undef PG8_WAIT_V
#undef PG8_WAIT_L
#undef PG8_BAR
#undef PG8_SCHED
}
}

#ifndef PG8_SP2
#define PG8_SP2 true
#endif
#ifndef PG8_ALIGN
#define PG8_ALIGN true
#endif
namespace pg8 {
struct EpiF32 {
    static constexpr bool PERM = false, AFTER_DRAIN = false;
    float* O; int ldc;
    __device__ __forceinline__ void operator()(const f32x4 (&acc)[2][2][4][2], const Unit& u, int wr, int wc, int fr, int fq) const {
        const int col0 = u.pn * BM + wc * 32 + 4 * fq;
#pragma unroll
        for (int ai = 0; ai < 2; ++ai)
#pragma unroll
            for (int m = 0; m < 4; ++m) { float* rowp = O + (size_t)(u.pm * BM + ai * HALF + wr * 64 + m * 16 + fr) * ldc + col0;
#pragma unroll
                for (int bj = 0; bj < 2; ++bj)
#pragma unroll
                    for (int n = 0; n < 2; ++n) *(f32x4*)(rowp + bj * HALF + n * 16) = acc[ai][bj][m][n]; }
    }
};
}
#define GAS __attribute__((address_space(1)))
#define LAS __attribute__((address_space(3)))
typedef unsigned short bf16;
typedef unsigned v4u __attribute__((ext_vector_type(4)));
typedef float f32x4 __attribute__((ext_vector_type(4)));
typedef short bf16x8 __attribute__((ext_vector_type(8)));
typedef GAS unsigned gu32;
typedef GAS unsigned long long gu64;
#define RLX_AGENT __ATOMIC_RELAXED, __HIP_MEMORY_SCOPE_AGENT
#define LDS_WAIT() asm volatile("s_waitcnt lgkmcnt(0)" ::: "memory")
#define VM_WAIT() asm volatile("s_waitcnt vmcnt(0)" ::: "memory")
__device__ __forceinline__ unsigned long long rt() { return __builtin_amdgcn_s_memrealtime(); }
__device__ __forceinline__ unsigned f2bf(float f) { unsigned u = __builtin_bit_cast(unsigned, f); return (u + 0x7fffu + ((u >> 16) & 1u)) >> 16; }
__device__ __forceinline__ unsigned pk2(float lo, float hi) { return f2bf(lo) | (f2bf(hi) << 16); }

#define XB_TMO      128
#define XB_XCNT(j)  (256  + 64 * (j))
#define XB_XSUB(j)  (1280 + 64 * (j))
#define XB_XGEN(j)  (2304 + 64 * (j))
#define XB_TOP      3328
#define XB_TOPGEN   3392
#define XCD_BAR_WORDS 3456
#define XB_SPIN_CAP (1u << 18)

__device__ __forceinline__ unsigned xb_ld(unsigned* p)              { return __hip_atomic_load(p, __ATOMIC_RELAXED, __HIP_MEMORY_SCOPE_AGENT); }
__device__ __forceinline__ unsigned xb_add(unsigned* p, unsigned v) { return __hip_atomic_fetch_add(p, v, __ATOMIC_RELAXED, __HIP_MEMORY_SCOPE_AGENT); }
__device__ __forceinline__ unsigned xb_xcc_id() { return (unsigned)__builtin_amdgcn_s_getreg((3 << 11) | 20) & 0xFu; }
#define XB_SPIN(cond, bar) do { unsigned _sp = 0; while (cond) { __builtin_amdgcn_s_sleep(1); \
    if ((++_sp & 255u) == 0u) { if (xb_ld(&(bar)[XB_TMO])) break; if (_sp > XB_SPIN_CAP) { atomicAdd(&(bar)[XB_TMO], 1u); break; } } } } while (0)

struct XcdBarrier {
    unsigned* bar; unsigned x;
    volatile LAS unsigned* st;
};

__device__ __forceinline__ XcdBarrier xcd_barrier_post(unsigned* bar, volatile LAS unsigned* st) {
    XcdBarrier b; b.bar = bar; b.x = xb_xcc_id(); b.st = st;
    if (threadIdx.x == 0) (void)xb_add(&bar[XB_XCNT(b.x)], 1u);
    return b;
}
__device__ __forceinline__ void xcd_barrier_complete(unsigned* bar, unsigned x, unsigned& nloc, unsigned& nx) {
    const unsigned G = gridDim.x * gridDim.y * gridDim.z;
    unsigned sum, cnt, mine, sp = 0u;
    for (;;) {
        sum = 0u; cnt = 0u; mine = 0u;
#pragma unroll
        for (unsigned j = 0; j < 16; ++j) { const unsigned c = xb_ld(&bar[XB_XCNT(j)]); sum += c; cnt += (c > 0u) ? 1u : 0u; mine = (j == x) ? c : mine; }
        if (sum == G) break;
        __builtin_amdgcn_s_sleep(1);
        if ((++sp & 255u) == 0u) { if (xb_ld(&bar[XB_TMO])) break; if (sp > XB_SPIN_CAP) { atomicAdd(&bar[XB_TMO], 1u); break; } }
    }
    nloc = mine > 0u ? mine : 1u; nx = cnt > 0u ? cnt : 1u;
}

__device__ __forceinline__ void xcd_barrier(const XcdBarrier& b) {
    asm volatile("s_waitcnt vmcnt(0)" ::: "memory");
    __syncthreads();
    if (threadIdx.x == 0) {
        unsigned* bar = b.bar;
        __builtin_amdgcn_s_waitcnt(0);
        unsigned nloc = b.st[0], nx = b.st[1];
        if (nloc == 0u) { xcd_barrier_complete(bar, b.x, nloc, nx); b.st[0] = nloc; b.st[1] = nx; }
        const unsigned old = xb_add(&bar[XB_XSUB(b.x)], 1u);
        const unsigned gen = old / nloc;
        if (old + 1u == (gen + 1u) * nloc) {
            __builtin_amdgcn_fence(__ATOMIC_RELEASE, "agent");
            asm volatile("s_waitcnt vmcnt(0)" ::: "memory");
            const unsigned og = xb_add(&bar[XB_TOP], 1u);
            const unsigned tg = og / nx;
            if (og + 1u == (tg + 1u) * nx) xb_add(&bar[XB_TOPGEN], 1u);
            else XB_SPIN(xb_ld(&bar[XB_TOPGEN]) == tg, bar);
            __builtin_amdgcn_fence(__ATOMIC_ACQUIRE, "agent");
            xb_add(&bar[XB_XGEN(b.x)], 1u);
            asm volatile("s_waitcnt vmcnt(0)" ::: "memory");
        } else {
            XB_SPIN(xb_ld(&bar[XB_XGEN(b.x)]) == gen, bar);
            __builtin_amdgcn_fence(__ATOMIC_ACQUIRE, "agent");
            asm volatile("s_waitcnt vmcnt(0)" ::: "memory");
        }
    }
    __syncthreads();
}
constexpr int NWAVES = 8;
constexpr int BATCH = 4, SEQ = 4096, D = 1024, NH = 16, HD = 64, FF = 2816, FF2 = 2 * FF, DH2 = 8, DV = 128;
constexpr int M = BATCH * SEQ;
constexpr int AWIN_LD = 3 * D + NH;
constexpr float LN_EPS = 1e-5f, RMS_EPS = 1e-5f;
constexpr float DN_ALPHA = 1.4142135623730951f;
constexpr float LAMBDA_INIT = 0.35550906759096926f;
constexpr float C2 = 0.125f * 1.4426950408889634f;
constexpr float LOG2E = 1.4426950408889634f;

constexpr size_t MiB = 1u << 20;
constexpr size_t WS_CTL = 0, CTL_ZERO_BYTES = 1 * MiB;
constexpr size_t WS_COS = 1 * MiB, WS_SIN = WS_COS + 512 * 1024;
constexpr size_t WS_FLOG = 2 * MiB;
constexpr size_t WS_CK = 3 * MiB;
constexpr size_t WS_X = 5 * MiB;
constexpr size_t WS_WQKV0 = 8 * MiB, WS_WO0 = 14 * MiB, WS_WQKV1 = 16 * MiB, WS_WO1 = 22 * MiB;
constexpr size_t WS_WIN0 = 24 * MiB, WS_WIN1 = 35 * MiB, WS_WOUT0 = 46 * MiB, WS_WOUT1 = 52 * MiB;
constexpr size_t WS_XB = 58 * MiB;
constexpr size_t WS_QO = 90 * MiB, WS_KB = 122 * MiB, WS_VB = 154 * MiB;
constexpr size_t WS_HS = 186 * MiB;
constexpr size_t WS_UH = 90 * MiB;
constexpr size_t WS_HH = 178 * MiB;
constexpr size_t WS_HSH = 222 * MiB;
constexpr size_t WS_END = 256 * MiB;
static_assert(WS_UH + (size_t)(M / 2) * FF2 * 2 <= WS_HH && WS_HH + (size_t)(M / 2) * FF * 2 <= WS_HSH && WS_HSH + (size_t)(M / 2) * D * 4 <= WS_END, "ffn map");
static_assert(WS_HS + (size_t)M * D * 4 <= WS_END && WS_VB + (size_t)M * D * 2 <= WS_HS && WS_XB + (size_t)M * D * 2 <= WS_QO, "attn map");
constexpr int CW_TMO = 0, CW_CODE = 1, CW_BAR = 4096, CW_SEAM = 16384, SEAM_BANK = 128 * 64;

constexpr int RING_OFF = 0, RING_BYTES = 131072;
constexpr int LDSCTL_OFF = RING_BYTES, MISC_OFF = LDSCTL_OFF + 320;
constexpr int LDS_BYTES = 147456;

struct Frame {
    LAS unsigned char* lds;
    volatile LAS unsigned* MISC;
    gu32* ctl;
    int tid, lane, wave;
    int vcu, G;
};
struct Args { const float* in[17]; float* out; unsigned char* ws; int ph_lo, ph_hi; };

__device__ __forceinline__ float wave_sum(float v) {
#pragma unroll
    for (int o = 1; o < 64; o <<= 1) v += __shfl_xor(v, o);
    return v;
}
__device__ __forceinline__ float bf2f(unsigned short h) { return __uint_as_float((unsigned)h << 16); }

__device__ __forceinline__ int map_row(int mode, int off, int n) {
    if (mode == 1) {
        const int g = n & ~63, d = n & 63;
        const int p = d < 32 ? 8 * (d >> 2) + (d & 3) : 8 * ((d - 32) >> 2) + 4 + (d & 3);
        return off + g + p;
    }
    if (mode == 2) {
        return n < FF ? 256 * (n >> 7) + (n & 127) : 256 * ((n - FF) >> 7) + 128 + ((n - FF) & 127);
    }
    return off + n;
}
__device__ __forceinline__ void p0_transpose_item(const float* W, int ldw, int K, int nblk, bf16* WT, int mode, int off, LAS float* scr, int item, int lane) {
    const int kb = item / nblk, nb = item % nblk, k0 = 64 * kb, n0 = 32 * nb;
#pragma unroll 8
    for (int i = 0; i < 32; ++i) { const int kk = 2 * i + (lane >> 5); scr[kk * 33 + (lane & 31)] = W[(size_t)(k0 + kk) * ldw + n0 + (lane & 31)]; }
    LDS_WAIT(); asm volatile("" ::: "memory");
    const int c = lane & 7;
#pragma unroll
    for (int j = 0; j < 4; ++j) { const int n = (lane >> 3) + 8 * j; const LAS float* s = scr + (8 * c) * 33 + n;
        v4u o; o.x = pk2(s[0 * 33], s[1 * 33]); o.y = pk2(s[2 * 33], s[3 * 33]); o.z = pk2(s[4 * 33], s[5 * 33]); o.w = pk2(s[6 * 33], s[7 * 33]);
        *(GAS v4u*)(WT + (size_t)map_row(mode, off, n0 + n) * K + k0 + 8 * c) = o; }
    LDS_WAIT(); asm volatile("" ::: "memory");
}
__device__ __forceinline__ void sincos_d(double x, double& s, double& c) {
    const double n = __builtin_rint(x * 0.63661977236758134308);
    double r = __builtin_fma(-n, 1.57079632679489655800, x); r = __builtin_fma(-n, 6.12323399573676603587e-17, r);
    const double r2 = r * r;
    double sp = -7.6471637318198164759e-13; sp = __builtin_fma(sp, r2, 1.6059043836821614599e-10); sp = __builtin_fma(sp, r2, -2.5052108385441718775e-08);
    sp = __builtin_fma(sp, r2, 2.7557319223985890653e-06); sp = __builtin_fma(sp, r2, -1.9841269841269841270e-04); sp = __builtin_fma(sp, r2, 8.3333333333333333333e-03);
    sp = __builtin_fma(sp, r2, -1.6666666666666666667e-01); const double sr = __builtin_fma(sp * r2, r, r);
    double cp = 4.7794773323873852974e-14; cp = __builtin_fma(cp, r2, -1.1470745597729724714e-11); cp = __builtin_fma(cp, r2, 2.0876756987868098979e-09);
    cp = __builtin_fma(cp, r2, -2.7557319223985890653e-07); cp = __builtin_fma(cp, r2, 2.4801587301587301587e-05); cp = __builtin_fma(cp, r2, -1.3888888888888888889e-03);
    cp = __builtin_fma(cp, r2, 4.1666666666666666667e-02); cp = __builtin_fma(cp, r2, -0.5); const double cr = __builtin_fma(cp, r2, 1.0);
    const int q = ((int)n) & 3;
    s = (q == 0) ? sr : (q == 1) ? cr : (q == 2) ? -sr : -cr;
    c = (q == 0) ? cr : (q == 1) ? -sr : (q == 2) ? -cr : sr;
}

__device__ __forceinline__ void p0_prologue(Frame& F, const Args& args) {
    unsigned char* ws = args.ws;
    LAS float* scr = (LAS float*)(F.lds + RING_OFF + F.wave * 16384);
    const int gw = F.vcu * NWAVES + F.wave, NGW = F.G * NWAVES;
    constexpr int I0 = 16 * 96, I1 = 16 * 32, I7 = 16 * 176, I9 = 44 * 32;
    constexpr int NITEMS = I0 + 5 * I1 + 2 * I7 + 2 * I9;
    for (int it = gw; it < NITEMS; it += NGW) {
        int r = it; const float* W; int ldw, K, nblk, mode = 0, off = 0; size_t dst;
        if (r < I0) { W = args.in[1]; ldw = AWIN_LD; K = D; nblk = 96; dst = WS_WQKV0; }
        else if ((r -= I0) < I1) { W = args.in[3]; ldw = D; K = D; nblk = 32; dst = WS_WO0; }
        else if ((r -= I1) < I1) { W = args.in[5]; ldw = D; K = D; nblk = 32; dst = WS_WQKV1; mode = 1; }
        else if ((r -= I1) < I1) { W = args.in[4]; ldw = 2 * D; K = D; nblk = 32; dst = WS_WQKV1; mode = 1; off = D; }
        else if ((r -= I1) < I1) { W = args.in[4] + D; ldw = 2 * D; K = D; nblk = 32; dst = WS_WQKV1; off = 2 * D; }
        else if ((r -= I1) < I1) { W = args.in[8]; ldw = D; K = D; nblk = 32; dst = WS_WO1; }
        else if ((r -= I1) < I7) { W = args.in[9]; ldw = FF2; K = D; nblk = 176; dst = WS_WIN0; mode = 2; }
        else if ((r -= I7) < I7) { W = args.in[9] + (size_t)D * FF2; ldw = FF2; K = D; nblk = 176; dst = WS_WIN1; mode = 2; }
        else if ((r -= I7) < I9) { W = args.in[12]; ldw = D; K = FF; nblk = 32; dst = WS_WOUT0; }
        else { r -= I9; W = args.in[12] + (size_t)FF * D; ldw = D; K = FF; nblk = 32; dst = WS_WOUT1; }
        p0_transpose_item(W, ldw, K, nblk, (bf16*)(ws + dst), mode, off, scr, r, F.lane);
    }
    {
        float* cosT = (float*)(ws + WS_COS); float* sinT = (float*)(ws + WS_SIN);
        for (int e = (int)blockIdx.x * (NWAVES * 64) + F.tid; e < SEQ * 32; e += F.G * NWAVES * 64) {
            const int pos = e >> 5, i = e & 31;
            double invd = 1.0; for (int q_ = 0; q_ < i; ++q_) invd *= 0.7498942093324559;
            const float inv = (float)invd;
            const float ang = (float)pos * inv;
            double s, c; sincos_d((double)ang, s, c);
            cosT[e] = (float)c; sinT[e] = (float)s;
        }
    }
    __syncthreads();
    {
        LAS float* wf = (LAS float*)(F.lds + RING_OFF);
        const float* Win = args.in[1];
        for (int e = F.tid; e < 16 * D; e += NWAVES * 64) { const int k = e >> 4, h = e & 15; wf[h * D + k] = Win[(size_t)k * AWIN_LD + 3 * D + h]; }
        __syncthreads();
        const float* x = args.in[0]; bf16* XB = (bf16*)(ws + WS_XB); float* flog = (float*)(ws + WS_FLOG); const float* bfv = args.in[2];
        for (int m = gw; m < M; m += NGW) {
            const GAS f32x4* xr = (const GAS f32x4*)(x + (size_t)m * D) + F.lane;
            f32x4 v[4];
#pragma unroll
            for (int j = 0; j < 4; ++j) v[j] = xr[64 * j];
            GAS unsigned long long* o8 = (GAS unsigned long long*)(XB + (size_t)m * D) + F.lane;
#pragma unroll
            for (int j = 0; j < 4; ++j) o8[64 * j] = (unsigned long long)pk2(v[j].x, v[j].y) | ((unsigned long long)pk2(v[j].z, v[j].w) << 32);
            float mine = 0.f;
#pragma unroll 2
            for (int h = 0; h < 16; ++h) {
                float a = 0.f;
#pragma unroll
                for (int j = 0; j < 4; ++j) { const f32x4 w = *(const LAS f32x4*)(wf + h * D + 256 * j + 4 * F.lane); a += (v[j].x * w.x + v[j].y * w.y) + (v[j].z * w.z + v[j].w * w.w); }
                a = wave_sum(a);
                if (F.lane == h) mine = a;
            }
            if (F.lane < 16) flog[(size_t)m * 16 + F.lane] = mine + bfv[F.lane];
        }
    }
    __syncthreads();
}

__device__ __forceinline__ void scan_phase(Frame& F, const Args& args) {
    if (blockIdx.x >= BATCH * NH) return;
    const int bh = blockIdx.x, b = bh >> 4, h = bh & 15;
    const float* flog = (const float*)(args.ws + WS_FLOG); double* ck = (double*)(args.ws + WS_CK) + (size_t)bh * SEQ;
    LAS double* wtot = (LAS double*)(F.lds + RING_OFF);
    double loc[8]; double run = 0.0;
#pragma unroll
    for (int e = 0; e < 8; ++e) {
        const float f = flog[(size_t)(b * SEQ + F.tid * 8 + e) * 16 + h];
        const float ls = fminf(f, 0.f) - log1pf(expf(-fabsf(f)));
        run += (double)ls * 1.4426950408889634; loc[e] = run;
    }
    double inc = run;
#pragma unroll
    for (int o = 1; o < 64; o <<= 1) { const double t = __shfl_up(inc, o); if (F.lane >= o) inc += t; }
    if (F.lane == 63) wtot[F.wave] = inc;
    __syncthreads();
    double base = inc - run;
    for (int w = 0; w < F.wave; ++w) base += wtot[w];
#pragma unroll
    for (int e = 0; e < 8; ++e) ck[F.tid * 8 + e] = base + loc[e];
    __syncthreads();
}

__device__ __forceinline__ void ln_phase(Frame& F, const float* xin, const float* hs, const float* g, const float* bta, float* xout, bf16* xb, int row0, int nrows) {
    const int gw = F.vcu * NWAVES + F.wave, NGW = F.G * NWAVES;
    for (int r = gw; r < nrows; r += NGW) {
        const int m = row0 + r;
        const GAS f32x4* xr = (const GAS f32x4*)(xin + (size_t)m * D) + F.lane;
        const GAS f32x4* hr = (const GAS f32x4*)(hs + (size_t)r * D) + F.lane;
        f32x4 v[4]; float s = 0.f;
#pragma unroll
        for (int j = 0; j < 4; ++j) { v[j] = xr[64 * j] * DN_ALPHA + hr[64 * j]; s += (v[j].x + v[j].y) + (v[j].z + v[j].w); }
        const float mean = wave_sum(s) * (1.f / D); float s2 = 0.f;
#pragma unroll
        for (int j = 0; j < 4; ++j) { v[j] = v[j] - mean; s2 += (v[j].x * v[j].x + v[j].y * v[j].y) + (v[j].z * v[j].z + v[j].w * v[j].w); }
        const float rstd = 1.f / sqrtf(wave_sum(s2) * (1.f / D) + LN_EPS);
        GAS f32x4* xo = (GAS f32x4*)(xout + (size_t)m * D) + F.lane;
        GAS unsigned long long* o8 = (GAS unsigned long long*)(xb + (size_t)m * D) + F.lane;
#pragma unroll
        for (int j = 0; j < 4; ++j) {
            const f32x4 gg = *((const GAS f32x4*)g + F.lane + 64 * j), bb = *((const GAS f32x4*)bta + F.lane + 64 * j);
            const f32x4 y = v[j] * rstd * gg + bb;
            xo[64 * j] = y;
            o8[64 * j] = (unsigned long long)pk2(y.x, y.y) | ((unsigned long long)pk2(y.z, y.w) << 32);
        }
    }
}

__device__ __forceinline__ void conv_gate_phase(Frame& F, const bf16* U, const float* cw, const float* cb, bf16* Hh, int row0, int nrows) {
    const int NCH = FF / 8;
    const long total = (long)nrows * NCH;
    for (long it = (long)blockIdx.x * (NWAVES * 64) + F.tid; it < total; it += (long)F.G * NWAVES * 64) {
        const int lr = (int)(it / NCH), c8 = (int)(it % NCH), c = c8 * 8;
        const int s = (row0 + lr) % SEQ;
        const int ug = 256 * (c >> 7) + (c & 127), uv = ug + 128;
        float g[8], vv[8];
#pragma unroll
        for (int e = 0; e < 8; ++e) { g[e] = cb[c + e]; vv[e] = cb[FF + c + e]; }
#pragma unroll
        for (int j = 0; j < 3; ++j) {
            const int back = 2 - j;
            if (s >= back) {
                const bf16x8 a = *(const GAS bf16x8*)(U + (size_t)(lr - back) * FF2 + ug);
                const bf16x8 bq = *(const GAS bf16x8*)(U + (size_t)(lr - back) * FF2 + uv);
#pragma unroll
                for (int e = 0; e < 8; ++e) { g[e] += cw[j * FF2 + c + e] * bf2f((unsigned short)a[e]); vv[e] += cw[j * FF2 + FF + c + e] * bf2f((unsigned short)bq[e]); }
            }
        }
        v4u o; float r[8];
#pragma unroll
        for (int e = 0; e < 8; ++e) r[e] = g[e] / (1.f + expf(-g[e])) * vv[e];
        o.x = pk2(r[0], r[1]); o.y = pk2(r[2], r[3]); o.z = pk2(r[4], r[5]); o.w = pk2(r[6], r[7]);
        *(GAS v4u*)(Hh + (size_t)lr * FF + c) = o;
    }
}

__device__ __forceinline__ void rope_phase(Frame& F, bf16* Q1, bf16* K12, const float* cosT, const float* sinT) {
    const long total = (long)M * 256;
    for (long it = (long)blockIdx.x * (NWAVES * 64) + F.tid; it < total; it += (long)F.G * NWAVES * 64) {
        const int t = (int)(it >> 8), w = (int)(it & 255), ch = w & 127; bf16* buf = (w >> 7) ? K12 : Q1;
        const int a = ch & 7, s = t % SEQ;
        bf16* p = buf + (size_t)t * D + ch * 8;
        const bf16x8 v = *(const GAS bf16x8*)p;
        const f32x4 cs = *(const GAS f32x4*)(cosT + s * 32 + 4 * a), sn = *(const GAS f32x4*)(sinT + s * 32 + 4 * a);
        float o[8];
#pragma unroll
        for (int e = 0; e < 4; ++e) { const float t1 = bf2f((unsigned short)v[e]), t2 = bf2f((unsigned short)v[4 + e]); o[e] = t1 * cs[e] - t2 * sn[e]; o[4 + e] = t2 * cs[e] + t1 * sn[e]; }
        v4u ov; ov.x = pk2(o[0], o[1]); ov.y = pk2(o[2], o[3]); ov.z = pk2(o[4], o[5]); ov.w = pk2(o[6], o[7]);
        *(GAS v4u*)p = ov;
    }
}

__device__ __forceinline__ void attn_fox_simple(Frame& F, const bf16* Q, const bf16* K, const bf16* V, bf16* O, const double* ck) {
    LAS float* Ks = (LAS float*)(F.lds + RING_OFF);
    LAS float* Vs = (LAS float*)(F.lds + RING_OFF + 16384);
    LAS double* cks = (LAS double*)(F.lds + RING_OFF + 32768);
    const int bh = (int)blockIdx.x >> 2, jj = (int)blockIdx.x & 3, b = bh >> 4, h = bh & 15;
    for (int ui = 0; ui < 2; ++ui) {
        const int rb = ui == 0 ? jj : 7 - jj, q0 = rb * 512, row = q0 + F.tid;
        const size_t t = (size_t)b * SEQ + row;
        float q[64];
#pragma unroll
        for (int c = 0; c < 8; ++c) { const bf16x8 v = *(const GAS bf16x8*)(Q + t * D + h * 64 + c * 8);
#pragma unroll
            for (int e = 0; e < 8; ++e) q[c * 8 + e] = bf2f((unsigned short)v[e]); }
        const double cq = ck[(size_t)bh * SEQ + row];
        float o[64];
#pragma unroll
        for (int d = 0; d < 64; ++d) o[d] = 0.f;
        float mrun = -INFINITY, l = 0.f;
        const int nkt = (q0 + 512) / 64;
        for (int kt = 0; kt < nkt; ++kt) {
            __syncthreads();
            { const int r = F.tid >> 3, c = F.tid & 7; const size_t kr = ((size_t)b * SEQ + kt * 64 + r) * D + h * 64 + c * 8;
              const bf16x8 kv = *(const GAS bf16x8*)(K + kr); const bf16x8 vv = *(const GAS bf16x8*)(V + kr);
#pragma unroll
              for (int e = 0; e < 8; ++e) { Ks[r * 64 + c * 8 + e] = bf2f((unsigned short)kv[e]); Vs[r * 64 + c * 8 + e] = bf2f((unsigned short)vv[e]); }
              if (F.tid < 64) cks[F.tid] = ck[(size_t)bh * SEQ + kt * 64 + F.tid]; }
            __syncthreads();
            if (kt * 64 <= row) {
                for (int j = 0; j < 64; ++j) {
                    float s = 0.f;
#pragma unroll
                    for (int d = 0; d < 64; d += 4) { const f32x4 kk = *(const LAS f32x4*)(Ks + j * 64 + d); s += (q[d] * kk.x + q[d + 1] * kk.y) + (q[d + 2] * kk.z + q[d + 3] * kk.w); }
                    s += (float)(cq - cks[j]);
                    if (kt * 64 + j > row) s = -INFINITY;
                    if (s > mrun) { const float sc = exp2f(mrun - s); l *= sc;
#pragma unroll
                        for (int d = 0; d < 64; ++d) o[d] *= sc;
                        mrun = s; }
                    const float p = exp2f(s - mrun); l += p;
#pragma unroll
                    for (int d = 0; d < 64; d += 4) { const f32x4 vv = *(const LAS f32x4*)(Vs + j * 64 + d); o[d] += p * vv.x; o[d + 1] += p * vv.y; o[d + 2] += p * vv.z; o[d + 3] += p * vv.w; }
                }
            }
        }
        const float inv = 1.f / l;
#pragma unroll
        for (int c = 0; c < 8; ++c) { v4u w; w.x = pk2(o[c * 8] * inv, o[c * 8 + 1] * inv); w.y = pk2(o[c * 8 + 2] * inv, o[c * 8 + 3] * inv); w.z = pk2(o[c * 8 + 4] * inv, o[c * 8 + 5] * inv); w.w = pk2(o[c * 8 + 6] * inv, o[c * 8 + 7] * inv);
            *(GAS v4u*)(O + t * D + h * 64 + c * 8) = w; }
    }
    __syncthreads();
}
__device__ __forceinline__ void attn_diff_simple(Frame& F, const bf16* Q1, const bf16* K12, const bf16* V, bf16* O, float* S1, const float* lamp, const float* subg) {
    LAS float* Ks = (LAS float*)(F.lds + RING_OFF);
    LAS float* Vs = (LAS float*)(F.lds + RING_OFF + 16384);
    float s01 = 0.f, s23 = 0.f;
    for (int e = 0; e < 64; ++e) { s01 += lamp[e] * lamp[64 + e]; s23 += lamp[128 + e] * lamp[192 + e]; }
    const float lam = expf(s01) - expf(s23) + LAMBDA_INIT;
    const int bh = (int)blockIdx.x >> 3, jj = (int)blockIdx.x & 7, b = bh >> 3, h = bh & 7;
    const int half = F.tid & 1;
    for (int ui = 0; ui < 2; ++ui) {
        const int rb = ui == 0 ? jj : 15 - jj, q0 = rb * 256, row = q0 + (F.tid >> 1);
        const size_t t = (size_t)b * SEQ + row;
        const int nkt = (q0 + 256) / 64;
        for (int i = 0; i < 2; ++i) {
            float q[64];
#pragma unroll
            for (int c = 0; c < 8; ++c) { const bf16x8 v = *(const GAS bf16x8*)(Q1 + t * D + i * 512 + h * 64 + c * 8);
#pragma unroll
                for (int e = 0; e < 8; ++e) q[c * 8 + e] = bf2f((unsigned short)v[e]); }
            float o[64];
#pragma unroll
            for (int d = 0; d < 64; ++d) o[d] = 0.f;
            float mrun = -INFINITY, l = 0.f;
            for (int kt = 0; kt < nkt; ++kt) {
                __syncthreads();
                { const int r = F.tid >> 3, c = F.tid & 7; const size_t rowk = (size_t)b * SEQ + kt * 64 + r;
                  const bf16x8 kv = *(const GAS bf16x8*)(K12 + rowk * D + i * 512 + h * 64 + c * 8);
                  const bf16x8 v0 = *(const GAS bf16x8*)(V + rowk * D + h * 128 + c * 16); const bf16x8 v1 = *(const GAS bf16x8*)(V + rowk * D + h * 128 + c * 16 + 8);
#pragma unroll
                  for (int e = 0; e < 8; ++e) { Ks[r * 64 + c * 8 + e] = bf2f((unsigned short)kv[e]); Vs[r * 128 + c * 16 + e] = bf2f((unsigned short)v0[e]); Vs[r * 128 + c * 16 + 8 + e] = bf2f((unsigned short)v1[e]); } }
                __syncthreads();
                if (kt <= (row >> 6)) {
                    for (int j = 0; j < 64; ++j) {
                        float s = 0.f;
#pragma unroll
                        for (int d = 0; d < 64; d += 4) { const f32x4 kk = *(const LAS f32x4*)(Ks + j * 64 + d); s += (q[d] * kk.x + q[d + 1] * kk.y) + (q[d + 2] * kk.z + q[d + 3] * kk.w); }
                        if (s > mrun) { const float sc = exp2f(mrun - s); l *= sc;
#pragma unroll
                            for (int d = 0; d < 64; ++d) o[d] *= sc;
                            mrun = s; }
                        const float p = exp2f(s - mrun); l += p;
#pragma unroll
                        for (int d = 0; d < 64; d += 4) { const f32x4 vv = *(const LAS f32x4*)(Vs + j * 128 + half * 64 + d); o[d] += p * vv.x; o[d + 1] += p * vv.y; o[d + 2] += p * vv.z; o[d + 3] += p * vv.w; }
                    }
                }
            }
            const float inv = 1.f / l;
            float* sp = S1 + t * D + h * 128 + half * 64;
            if (i == 0) {
#pragma unroll
                for (int d = 0; d < 64; d += 4) *(GAS f32x4*)(sp + d) = (f32x4){o[d] * inv, o[d + 1] * inv, o[d + 2] * inv, o[d + 3] * inv};
            } else {
                float ss = 0.f;
#pragma unroll
                for (int d = 0; d < 64; d += 4) { const f32x4 a = *(const GAS f32x4*)(sp + d);
                    o[d] = a.x - lam * (o[d] * inv); o[d + 1] = a.y - lam * (o[d + 1] * inv); o[d + 2] = a.z - lam * (o[d + 2] * inv); o[d + 3] = a.w - lam * (o[d + 3] * inv);
                    ss += (o[d] * o[d] + o[d + 1] * o[d + 1]) + (o[d + 2] * o[d + 2] + o[d + 3] * o[d + 3]); }
                ss += __shfl_xor(ss, 1);
                const float rr = 1.f / sqrtf(ss * (1.f / 128.f) + RMS_EPS) * (1.f - LAMBDA_INIT);
#pragma unroll
                for (int c = 0; c < 8; ++c) { float y[8];
#pragma unroll
                    for (int e = 0; e < 8; ++e) y[e] = o[c * 8 + e] * rr * subg[half * 64 + c * 8 + e];
                    v4u w; w.x = pk2(y[0], y[1]); w.y = pk2(y[2], y[3]); w.z = pk2(y[4], y[5]); w.w = pk2(y[6], y[7]);
                    *(GAS v4u*)(O + t * D + h * 128 + half * 64 + c * 8) = w; }
            }
        }
    }
    __syncthreads();
}

enum Phase { PH_PRO = 0, PH_QKV0, PH_ATT0, PH_WO0, PH_LNA0,
             PH_UP0A, PH_CV0A, PH_DN0A, PH_LNF0A, PH_UP0B, PH_CV0B, PH_DN0B, PH_LNF0B,
             PH_QKV1, PH_ROPE1, PH_ATT1, PH_WO1, PH_LNA1,
             PH_UP1A, PH_CV1A, PH_DN1A, PH_LNF1A, PH_UP1B, PH_CV1B, PH_DN1B, PH_LNF1B, PH_COUNT };

#define EN(b) ((PHMASK >> (b)) & 1u)
template <unsigned PHMASK> __global__ void __launch_bounds__(NWAVES * 64, 2) yoco_fwd(Args args) {
    extern __shared__ __attribute__((aligned(16))) unsigned char lds[];
    Frame F;
    F.lds = (LAS unsigned char*)lds;
    F.MISC = (volatile LAS unsigned*)(F.lds + MISC_OFF);
    F.tid = threadIdx.x; F.lane = F.tid & 63; F.wave = __builtin_amdgcn_readfirstlane(F.tid >> 6);
    F.G = gridDim.x; { const int bx = blockIdx.x; F.vcu = (F.G % 8 == 0) ? (bx % 8) * (F.G / 8) + bx / 8 : bx; }
    unsigned char* ws = args.ws;
    F.ctl = (gu32*)(ws + WS_CTL);
    for (int u = F.tid; u < (LDS_BYTES - LDSCTL_OFF) / 4; u += NWAVES * 64) ((LAS unsigned*)(F.lds + LDSCTL_OFF))[u] = 0u;
    __syncthreads();
    XcdBarrier bar; bar.bar = (unsigned*)(F.ctl + CW_BAR); bar.x = 0; bar.st = nullptr;
    const bool multi = (args.ph_hi - args.ph_lo) > 1;
    if (multi) bar = xcd_barrier_post((unsigned*)(F.ctl + CW_BAR), F.MISC + 8);

    if (EN(2) && args.ph_lo == PH_PRO) p0_prologue(F, args);
    for (int ph = args.ph_lo; ph < args.ph_hi; ++ph) {
        { int t_ = threadIdx.x; asm volatile("" : "+v"(t_)); F.tid = t_; F.lane = t_ & 63; F.wave = __builtin_amdgcn_readfirstlane(t_ >> 6); }
        unsigned char* ws = args.ws; asm volatile("" : "+s"(ws));
        bf16* XB = (bf16*)(ws + WS_XB); bf16* QO = (bf16*)(ws + WS_QO); bf16* KB = (bf16*)(ws + WS_KB); bf16* VB = (bf16*)(ws + WS_VB);
        float* HS = (float*)(ws + WS_HS); bf16* UH = (bf16*)(ws + WS_UH); bf16* HH = (bf16*)(ws + WS_HH); float* HSH = (float*)(ws + WS_HSH);
        const float* cosT = (const float*)(ws + WS_COS); const float* sinT = (const float*)(ws + WS_SIN);

        int kind = 0; pg8::Gemm g{nullptr, nullptr, 0, 0, 0};
        bf16* ob = nullptr; int ob_ld = 0, ob_split = 0; size_t ob_stride = 0; float ob_scale = 1.f; float* of = nullptr;
        const int layer = ph >= PH_QKV1 ? 1 : 0;
        const bf16* WIN = (const bf16*)(ws + (layer ? WS_WIN1 : WS_WIN0)); const bf16* WOUT = (const bf16*)(ws + (layer ? WS_WOUT1 : WS_WOUT0));
        int half = 0;
        switch (ph) {
            case PH_QKV0: kind = 1; g = pg8::Gemm{XB, (const bf16*)(ws + WS_WQKV0), M, 3 * D, D}; ob = QO; ob_ld = D; ob_split = D; ob_stride = (WS_KB - WS_QO) / 2; ob_scale = C2; break;
            case PH_QKV1: kind = 1; g = pg8::Gemm{XB, (const bf16*)(ws + WS_WQKV1), M, 3 * D, D}; ob = QO; ob_ld = D; ob_split = D; ob_stride = (WS_KB - WS_QO) / 2; ob_scale = C2; break;
            case PH_WO0: kind = 2; g = pg8::Gemm{QO, (const bf16*)(ws + WS_WO0), M, D, D}; of = HS; break;
            case PH_WO1: kind = 2; g = pg8::Gemm{XB, (const bf16*)(ws + WS_WO1), M, D, D}; of = HS; break;
            case PH_UP0B: case PH_UP1B: half = 1; [[fallthrough]];
            case PH_UP0A: case PH_UP1A: kind = 1; g = pg8::Gemm{XB + (size_t)half * (M / 2) * D, WIN, M / 2, FF2, D}; ob = UH; ob_ld = FF2; break;
            case PH_DN0B: case PH_DN1B: half = 1; [[fallthrough]];
            case PH_DN0A: case PH_DN1A: kind = 2; g = pg8::Gemm{HH, WOUT, M / 2, D, FF}; of = HSH; break;
            case PH_CV0B: case PH_CV1B: case PH_LNF0B: case PH_LNF1B: half = 1; break;
            default: break;
        }
        if (EN(0) && kind == 1) {
            pg8::StaticOrder S; S.init(g.M, g.N, F.G, (int)blockIdx.x);
            pg8::EpiBf16<0> E{ob, ob_ld, nullptr, ob_split, ob_stride, ob_scale};
            if (ph == PH_QKV0) scan_phase(F, args);
            pg8::gemm_phase<pg8::EpiBf16<0>, pg8::StaticOrder, PG8_ALIGN, PG8_SP2>(F.lds + RING_OFF, g, S, E);
        } else if (EN(1) && kind == 2) {
            pg8::StaticOrder S; S.init(g.M, g.N, F.G, (int)blockIdx.x);
            pg8::EpiF32 E{of, D};
            pg8::gemm_phase<pg8::EpiF32, pg8::StaticOrder, PG8_ALIGN, PG8_SP2>(F.lds + RING_OFF, g, S, E);
        } else if (EN(3) && ph == PH_ATT0) {
            attn_fox_simple(F, QO, KB, VB, QO, (const double*)(ws + WS_CK));
        } else if (EN(4) && ph == PH_ATT1) {
            attn_diff_simple(F, QO, KB, VB, XB, HS, args.in[6], args.in[7]);
        } else if (EN(5) && ph == PH_ROPE1) {
            rope_phase(F, QO, KB, cosT, sinT);
        } else if (EN(6) && ph == PH_LNA0) {
            ln_phase(F, args.in[0], HS, args.in[13], args.in[14], args.out, XB, 0, M);
        } else if (EN(6) && ph == PH_LNA1) {
            ln_phase(F, args.out, HS, args.in[13] + D, args.in[14] + D, args.out, XB, 0, M);
        } else if (EN(7) && (ph == PH_CV0A || ph == PH_CV0B || ph == PH_CV1A || ph == PH_CV1B)) {
            conv_gate_phase(F, UH, args.in[10] + (size_t)layer * 3 * FF2, args.in[11] + (size_t)layer * FF2, HH, half * (M / 2), M / 2);
        } else if (EN(6) && (ph == PH_LNF0A || ph == PH_LNF0B || ph == PH_LNF1A || ph == PH_LNF1B)) {
            ln_phase(F, args.out, HSH, args.in[15] + (size_t)layer * D, args.in[16] + (size_t)layer * D, args.out, XB, half * (M / 2), M / 2);
        }
        if (ph + 1 < args.ph_hi) xcd_barrier(bar);
    }
}

#ifndef ONE_LAUNCH
#define ONE_LAUNCH 1
#endif
static unsigned phase_mask(int ph) {
    switch (ph) {
        case PH_QKV0: case PH_QKV1: case PH_UP0A: case PH_UP0B: case PH_UP1A: case PH_UP1B: return 0x1u;
        case PH_WO0: case PH_WO1: case PH_DN0A: case PH_DN0B: case PH_DN1A: case PH_DN1B: return 0x2u;
        case PH_PRO: return 0x4u;
        case PH_ATT0: return 0x8u;
        case PH_ATT1: return 0x10u;
        default: return 0xE0u;
    }
}
template <unsigned MASK> static void launch_one(int grid, const Args& a, hipStream_t stream) {
    static bool attr_done = false;
    if (!attr_done) { (void)hipFuncSetAttribute((const void*)yoco_fwd<MASK>, hipFuncAttributeMaxDynamicSharedMemorySize, LDS_BYTES); attr_done = true; }
    hipLaunchKernelGGL(yoco_fwd<MASK>, dim3(grid), dim3(NWAVES * 64), LDS_BYTES, stream, a);
}
extern "C" void kernel_launch(void* const* d_in, const int* in_sizes, int n_in, void* d_out, int out_size, void* d_ws, size_t ws_size, hipStream_t stream) {
    static int grid = 0;
    if (grid == 0) {
        if (n_in != 17 || out_size != M * D || ws_size < WS_END) { fprintf(stderr, "kernel_launch: unexpected shapes (n_in %d out %d ws %zu)\n", n_in, out_size, ws_size); grid = -1; return; }
        int dev = 0, cus = 0;
        if (hipGetDevice(&dev) != hipSuccess || hipDeviceGetAttribute(&cus, hipDeviceAttributeMultiprocessorCount, dev) != hipSuccess) { grid = -1; return; }
        (void)hipGetLastError();
        grid = cus;
        if (grid != 256) fprintf(stderr, "kernel_launch: %d CUs; this build expects 256\n", grid);
    }
    if (grid < 0) return;
    (void)hipMemsetAsync((char*)d_ws + WS_CTL, 0, CTL_ZERO_BYTES, stream);
    Args a{};
    for (int i = 0; i < 17; ++i) a.in[i] = (const float*)d_in[i];
    a.out = (float*)d_out; a.ws = (unsigned char*)d_ws;
#if ONE_LAUNCH
    a.ph_lo = 0; a.ph_hi = PH_COUNT; launch_one<0xFFu>(grid, a, stream);
#else
    for (int ph = 0; ph < PH_COUNT; ++ph) {
        a.ph_lo = ph; a.ph_hi = ph + 1;
        switch (phase_mask(ph)) {
            case 0x1u: launch_one<0x1u>(grid, a, stream); break;
            case 0x2u: launch_one<0x2u>(grid, a, stream); break;
            case 0x4u: launch_one<0x4u>(grid, a, stream); break;
            case 0x8u: launch_one<0x8u>(grid, a, stream); break;
            case 0x10u: launch_one<0x10u>(grid, a, stream); break;
            default: launch_one<0xE0u>(grid, a, stream); break;
        }
    }
#endif
}
```

```cpp
#include <hip/hip_runtime.h>
#include <hip/hip_bf16.h>
#include <cstdio>
#include <cstdint>
#include <cmath>
namespace pg8 {
#define PG8_LAS __attribute__((address_space(3)))
typedef unsigned short bf16_t;
typedef short bf16x8 __attribute__((ext_vector_type(8)));
typedef float f32x4 __attribute__((ext_vector_type(4)));
typedef unsigned u32x4 __attribute__((ext_vector_type(4)));
constexpr int BM = 256, BK = 64, HALF = 128, HTB = HALF * BK * 2  , STAGE_BYTES = 8 * HTB, NXCD = 8, WGM = 8;

__host__ __device__ __forceinline__ int lds_byte(int r, int c) { const int st = (r >> 4) * 2 + (c >> 5), rr = r & 15, cc = c & 31, ob = rr * 64 + cc * 2; return st * 1024 + (ob ^ (((ob >> 9) & 1) << 5)); }
__host__ __device__ __forceinline__ void stage_rc(int b, int& R, int& C) { const int st = b / 1024, sb = b % 1024, swz = sb ^ (((sb >> 9) & 1) << 5); R = (st >> 1) * 16 + swz / 64; C = (st & 1) * 32 + (swz % 64) / 2; }
__host__ __device__ __forceinline__ int perm32(int rho) { const int n = rho >> 4, i = rho & 15; return 8 * (i >> 2) + 4 * n + (i & 3); }

struct Unit { int pm, pn; };
struct Gemm { const bf16_t* A; const bf16_t* Bt; int M, N, K; };

struct StaticOrder {
    int nM, nN, nwg, G, c;
    __host__ __device__ void init(int M, int N, int G_, int c_) { nM = M / BM; nN = N / BM; nwg = nM * nN; G = G_; c = c_; }
    __host__ __device__ bool next(int i, Unit& u) const {
        const long L = (long)i * G + c; if (L >= nwg) return false;
        int wgid = (int)L; { const int q = nwg / NXCD, r = nwg % NXCD, xcd = wgid % NXCD, off = wgid / NXCD; wgid = (xcd < r ? xcd * (q + 1) : r * (q + 1) + (xcd - r) * q) + off; }
        const int nig = WGM * nN, gid = wgid / nig, fm = gid * WGM, gsz = (nM - fm) < WGM ? (nM - fm) : WGM;
        u.pm = fm + ((wgid % nig) % gsz); u.pn = (wgid % nig) / gsz; return true;
    }
    __device__ __forceinline__ void a_ready(const Unit&) const {}
    __device__ __forceinline__ void done(const Unit&) const {}
};

__device__ __forceinline__ unsigned cvt_pk_bf16(float lo, float hi) { unsigned r; asm volatile("v_cvt_pk_bf16_f32 %0, %1, %2" : "=v"(r) : "v"(lo), "v"(hi)); return r; }
typedef float f32x2 __attribute__((ext_vector_type(2)));
__device__ __forceinline__ f32x2 gelu_pk(f32x2 v) {
    const f32x2 av = __builtin_elementwise_abs(v), d = av * 0.2316418882f + 1.0f;
    f32x2 t; t.x = __builtin_amdgcn_rcpf(d.x); t.y = __builtin_amdgcn_rcpf(d.y);
    f32x2 q = t * 0.5307027145f + (-0.7265760135f); q = q * t + 0.7107068705f; q = q * t + (-0.142248368f); q = q * t + 0.127414796f; q = q * t;
    const f32x2 s = (v * v) * (-0.72134752044f);
    f32x2 e; e.x = __builtin_amdgcn_exp2f(s.x); e.y = __builtin_amdgcn_exp2f(s.y);
    const f32x2 m = v * (q * e), r = v - m;
    f32x2 o; o.x = v.x < 0.f ? m.x : r.x; o.y = v.y < 0.f ? m.y : r.y; return o;
}

template <int ACT  > struct EpiBf16 {
    static constexpr bool PERM = true, AFTER_DRAIN = false; static_assert(ACT == 0 || ACT == 1, "EpiBf16: ACT is 0 (none) or 1 (gelu_pk)");
    bf16_t* O; int ldc; const float* bias; int split_cols; size_t split_stride; float scale0;
    __device__ __forceinline__ void operator()(const f32x4 (&acc)[2][2][4][2], const Unit& u, int wr, int wc, int fr, int fq) const {
        const int row0 = u.pm * BM + wr * 64 + fr; int colt = u.pn * BM; bf16_t* base = O;
        float sc = 1.f; if (split_cols) { const int t = colt / split_cols; base += (size_t)t * split_stride; colt -= t * split_cols; if (t == 0) sc = scale0; }
        const int col0 = colt + wc * 32 + 8 * fq, bcol0 = u.pn * BM + wc * 32 + 8 * fq;
        f32x4 bv[2][2];
#pragma unroll
        for (int bj = 0; bj < 2; ++bj)
#pragma unroll
            for (int n = 0; n < 2; ++n) bv[bj][n] = bias ? *(const f32x4*)(bias + bcol0 + bj * HALF + 4 * n) : (f32x4){0.f, 0.f, 0.f, 0.f};
#pragma unroll
        for (int ai = 0; ai < 2; ++ai)
#pragma unroll
            for (int m = 0; m < 4; ++m) { bf16_t* rowp = base + (size_t)(row0 + ai * HALF + m * 16) * ldc + col0;
#pragma unroll
                for (int bj = 0; bj < 2; ++bj) { f32x4 v0 = acc[ai][bj][m][0] + bv[bj][0], v1 = acc[ai][bj][m][1] + bv[bj][1];
                    if (ACT == 1) { f32x2 a = gelu_pk((f32x2){v0[0], v0[1]}), b = gelu_pk((f32x2){v0[2], v0[3]}), c = gelu_pk((f32x2){v1[0], v1[1]}), d = gelu_pk((f32x2){v1[2], v1[3]});
                        v0 = (f32x4){a.x, a.y, b.x, b.y}; v1 = (f32x4){c.x, c.y, d.x, d.y}; }
                    v0 = v0 * sc; v1 = v1 * sc; u32x4 w; w.x = cvt_pk_bf16(v0[0], v0[1]); w.y = cvt_pk_bf16(v0[2], v0[3]); w.z = cvt_pk_bf16(v1[0], v1[1]); w.w = cvt_pk_bf16(v1[2], v1[3]);
                    *(u32x4*)(rowp + bj * HALF) = w; } }
    }
};

struct PanelStats {
    unsigned* xbuf;
    unsigned* cnt;
    unsigned* tmo;
    int ntn; float eps;
    unsigned code;
    __device__ __forceinline__ bool run(const f32x4 (&v)[2][2][4][2], const Unit& u, int wr, int wc, int fr, int fq, PG8_LAS unsigned char* lds, int wid, int lane) const {
        typedef float f32x2v __attribute__((ext_vector_type(2)));
        PG8_LAS f32x2v* P = (PG8_LAS f32x2v*)lds;
        PG8_LAS f32x2v* S = (PG8_LAS f32x2v*)(lds + 8192);
        PG8_LAS unsigned* flag = (PG8_LAS unsigned*)(lds + 8192 + 2048);
#pragma unroll
        for (int ai = 0; ai < 2; ++ai)
#pragma unroll
            for (int m = 0; m < 4; ++m) {
                float s = 0.f;
#pragma unroll
                for (int bj = 0; bj < 2; ++bj)
#pragma unroll
                    for (int n = 0; n < 2; ++n) { const f32x4 x = v[ai][bj][m][n]; s += (x[0] + x[1]) + (x[2] + x[3]); }
                s += __shfl_xor(s, 16); s += __shfl_xor(s, 32);
                const float mw = s * (1.0f / 64.0f); float q = 0.f;
#pragma unroll
                for (int bj = 0; bj < 2; ++bj)
#pragma unroll
                    for (int n = 0; n < 2; ++n) { const f32x4 d = v[ai][bj][m][n] - mw; q += (d[0] * d[0] + d[1] * d[1]) + (d[2] * d[2] + d[3] * d[3]); }
                q += __shfl_xor(q, 16); q += __shfl_xor(q, 32);
                if (fq == 0) P[(ai * HALF + wr * 64 + m * 16 + fr) * 4 + wc] = (f32x2v){mw, q};
            }
        asm volatile("s_waitcnt lgkmcnt(0)" ::: "memory"); __builtin_amdgcn_s_barrier(); asm volatile("" ::: "memory");
#if defined(BROKEN_EXCHANGE_NO_WAIT)
#warning BROKEN CONTROL BUILD: the row-statistics exchange does not wait; results are wrong by design
        if (blockIdx.x >= 64) { const long long t0_ = clock64(); while (clock64() - t0_ < 60000) __builtin_amdgcn_s_sleep(8); }
#endif
        const int row = wid * 32 + (lane & 31);
        if (lane < 32) {
            const f32x2v a = P[row * 4 + 0], b = P[row * 4 + 1], c = P[row * 4 + 2], d = P[row * 4 + 3];
            const float mt = (a.x + b.x + c.x + d.x) * 0.25f;
            const float da = a.x - mt, db = b.x - mt, dc = c.x - mt, dd = d.x - mt;
            const float m2 = (a.y + b.y) + (c.y + d.y) + 64.0f * ((da * da + db * db) + (dc * dc + dd * dd));
            unsigned long long* slot = (unsigned long long*)xbuf + ((size_t)(u.pm * BM + row) * 4 + u.pn);
            __hip_atomic_store(slot, ((unsigned long long)__float_as_uint(m2) << 32) | __float_as_uint(mt), __ATOMIC_RELAXED, __HIP_MEMORY_SCOPE_AGENT);
        }
        asm volatile("s_waitcnt vmcnt(0)" ::: "memory");
        if (lane == 0) __hip_atomic_fetch_add(cnt + 64 * u.pm, 1u, __ATOMIC_RELAXED, __HIP_MEMORY_SCOPE_AGENT);
        if (wid == 0) {
            bool dead = false; const unsigned long long t0 = __builtin_amdgcn_s_memrealtime(); const unsigned want = 8u * (unsigned)ntn;
            for (;;) {
#if defined(BROKEN_EXCHANGE_NO_WAIT)
                break;
#endif
                if ((unsigned)__builtin_amdgcn_readfirstlane(__hip_atomic_load(cnt + 64 * u.pm, __ATOMIC_RELAXED, __HIP_MEMORY_SCOPE_AGENT)) >= want) break;
                if (__builtin_amdgcn_s_memrealtime() - t0 > 2000000ull) {
                    if (lane == 0) { unsigned expect = 0u; __hip_atomic_compare_exchange_strong(tmo + 1, &expect, code | (unsigned)(u.pm & 0xff), __ATOMIC_RELAXED, __ATOMIC_RELAXED, __HIP_MEMORY_SCOPE_AGENT);
                                     __hip_atomic_store(tmo, 1u, __ATOMIC_RELAXED, __HIP_MEMORY_SCOPE_AGENT); }
                    dead = true; break; }
                __builtin_amdgcn_s_sleep(2);
            }
            __builtin_amdgcn_fence(__ATOMIC_ACQUIRE, "agent");
            if (lane == 0) flag[0] = dead ? 1u : 0u;
        }
        asm volatile("s_waitcnt vmcnt(0) lgkmcnt(0)" ::: "memory"); __builtin_amdgcn_s_barrier(); asm volatile("" ::: "memory");
        const bool bad = flag[0] != 0u;
        if (lane < 32) {
            const unsigned long long* slot = (const unsigned long long*)xbuf + (size_t)(u.pm * BM + row) * 4; float mt[4], m2[4]; float ms = 0.f;
#pragma unroll
            for (int t = 0; t < 4; ++t) { if (t < ntn) { const unsigned long long w = __hip_atomic_load(slot + t, __ATOMIC_RELAXED, __HIP_MEMORY_SCOPE_AGENT); mt[t] = __uint_as_float((unsigned)w); m2[t] = __uint_as_float((unsigned)(w >> 32)); } else { mt[t] = 0.f; m2[t] = 0.f; } ms += mt[t]; }
            const float mean = ms / (float)ntn; float q = 0.f;
#pragma unroll
            for (int t = 0; t < 4; ++t) if (t < ntn) { const float dm = mt[t] - mean; q += m2[t] + 256.0f * dm * dm; }
            S[row] = (f32x2v){mean, 1.0f / sqrtf(q / (256.0f * (float)ntn) + eps)};
        }
        asm volatile("s_waitcnt lgkmcnt(0)" ::: "memory"); __builtin_amdgcn_s_barrier(); asm volatile("" ::: "memory");
        return bad;
    }
};
struct EpiLnRes {
    static constexpr bool PERM = false, AFTER_DRAIN = true;
    const float* base; float* out; int ldc; const float* bias; PanelStats st; unsigned poison;
    __device__ __forceinline__ void fused(f32x4 (&acc)[2][2][4][2], const Unit& u, int wr, int wc, int fr, int fq, PG8_LAS unsigned char* lds, int wid, int lane) const {
        typedef float f32x2v __attribute__((ext_vector_type(2)));
        const PG8_LAS f32x2v* S = (const PG8_LAS f32x2v*)(lds + 8192);
        const int col0 = u.pn * BM + wc * 32 + 4 * fq;
#pragma unroll
        for (int bj = 0; bj < 2; ++bj)
#pragma unroll
            for (int n = 0; n < 2; ++n) { const f32x4 bv = bias ? *(const f32x4*)(bias + col0 + bj * HALF + n * 16) : (f32x4){0.f, 0.f, 0.f, 0.f};
#pragma unroll
                for (int ai = 0; ai < 2; ++ai)
#pragma unroll
                    for (int m = 0; m < 4; ++m) acc[ai][bj][m][n] += bv; }
        f32x4 pre[4][2][2];
#pragma unroll
        for (int m = 0; m < 4; ++m) { const size_t off = (size_t)(u.pm * BM + wr * 64 + m * 16 + fr) * ldc + col0;
#pragma unroll
            for (int bj = 0; bj < 2; ++bj)
#pragma unroll
                for (int n = 0; n < 2; ++n) pre[m][bj][n] = *(const f32x4*)(base + off + bj * HALF + n * 16); }
        const bool bad = st.run(acc, u, wr, wc, fr, fq, lds, wid, lane) || poison != 0u;
        const float qnan = __builtin_nanf("");
#pragma unroll
        for (int ai = 0; ai < 2; ++ai)
#pragma unroll
            for (int m = 0; m < 4; ++m) { const int r = ai * HALF + wr * 64 + m * 16 + fr; const f32x2v sr = S[r]; const size_t off = (size_t)(u.pm * BM + r) * ldc + col0;
#pragma unroll
                for (int bj = 0; bj < 2; ++bj)
#pragma unroll
                    for (int n = 0; n < 2; ++n) { const f32x4 bs = ai == 0 ? pre[m][bj][n] : *(const f32x4*)(base + off + bj * HALF + n * 16); f32x4 o = bs + (acc[ai][bj][m][n] - sr.x) * sr.y;
                        if (bad) o = (f32x4){qnan, qnan, qnan, qnan}; *(f32x4*)(out + off + bj * HALF + n * 16) = o; }
                if (m & 1) asm volatile("" ::: "memory"); }
    }
};
struct EpiLnResLn {
    static constexpr bool PERM = false, AFTER_DRAIN = true;
    const float* base; float* out; bf16_t* xn; int ldc; const float* bias; PanelStats st1, st2; unsigned poison;
    __device__ __forceinline__ void fused(f32x4 (&acc)[2][2][4][2], const Unit& u, int wr, int wc, int fr, int fq, PG8_LAS unsigned char* lds, int wid, int lane) const {
        typedef float f32x2v __attribute__((ext_vector_type(2))); typedef unsigned u32x2v __attribute__((ext_vector_type(2)));
        const PG8_LAS f32x2v* S = (const PG8_LAS f32x2v*)(lds + 8192);
        const int col0 = u.pn * BM + wc * 32 + 4 * fq;
#pragma unroll
        for (int bj = 0; bj < 2; ++bj)
#pragma unroll
            for (int n = 0; n < 2; ++n) { const f32x4 bv = bias ? *(const f32x4*)(bias + col0 + bj * HALF + n * 16) : (f32x4){0.f, 0.f, 0.f, 0.f};
#pragma unroll
                for (int ai = 0; ai < 2; ++ai)
#pragma unroll
                    for (int m = 0; m < 4; ++m) acc[ai][bj][m][n] += bv; }
        bool bad = st1.run(acc, u, wr, wc, fr, fq, lds, wid, lane) || poison != 0u;
        const float qnan = __builtin_nanf("");
#pragma unroll
        for (int ai = 0; ai < 2; ++ai)
#pragma unroll
            for (int m = 0; m < 4; ++m) { const int r = ai * HALF + wr * 64 + m * 16 + fr; const f32x2v sr = S[r]; const size_t off = (size_t)(u.pm * BM + r) * ldc + col0;
#pragma unroll
                for (int bj = 0; bj < 2; ++bj)
#pragma unroll
                    for (int n = 0; n < 2; ++n) { const f32x4 bs = *(const f32x4*)(base + off + bj * HALF + n * 16); acc[ai][bj][m][n] = bs + (acc[ai][bj][m][n] - sr.x) * sr.y; }
                asm volatile("" : "+v"(acc[ai][0][m][0]), "+v"(acc[ai][0][m][1]), "+v"(acc[ai][1][m][0]), "+v"(acc[ai][1][m][1]));
                if (m & 1) asm volatile("" ::: "memory"); }
        const bool bad1 = bad;
        bad = st2.run(acc, u, wr, wc, fr, fq, lds, wid, lane) || bad;
#pragma unroll
        for (int ai = 0; ai < 2; ++ai)
#pragma unroll
            for (int m = 0; m < 4; ++m) { const int r = ai * HALF + wr * 64 + m * 16 + fr; const f32x2v sr = S[r]; const size_t off = (size_t)(u.pm * BM + r) * ldc + col0;
#pragma unroll
                for (int bj = 0; bj < 2; ++bj)
#pragma unroll
                    for (int n = 0; n < 2; ++n) { const f32x4 x1 = acc[ai][bj][m][n]; *(f32x4*)(out + off + bj * HALF + n * 16) = bad1 ? (f32x4){qnan, qnan, qnan, qnan} : x1;
                        const f32x4 o = (x1 - sr.x) * sr.y; u32x2v w; w.x = cvt_pk_bf16(o[0], o[1]); w.y = cvt_pk_bf16(o[2], o[3]);
                        if (bad) { w.x = 0x7fc07fc0u; w.y = 0x7fc07fc0u; } *(u32x2v*)(xn + off + bj * HALF + n * 16) = w; }
                asm volatile("" ::: "memory"); }
    }
};

template <class Epi, class Sched, bool ALIGN_EPI = false, bool SP2 = false>
__device__ __forceinline__ void gemm_phase(PG8_LAS unsigned char* lds, const Gemm g, const Sched& S, const Epi& E) {
    int tid_ = threadIdx.x; asm volatile("" : "+v"(tid_));
    const int tid = tid_, wid = __builtin_amdgcn_readfirstlane(tid >> 6), lane = tid & 63, wr = wid >> 2, wc = wid & 3, fr = lane & 15, fq = lane >> 4;
    const int K = g.K, nt = K / BK;
    unsigned voffA[2], voffB[2];
#pragma unroll
    for (int i = 0; i < 2; ++i) { int R, C; stage_rc(tid * 16 + i * 8192, R, C); const int Rb = Epi::PERM ? ((R & ~31) + perm32(R & 31)) : R;
        voffA[i] = (unsigned)(R * K + C) * 2u; voffB[i] = (unsigned)(Rb * K + C) * 2u; }
    const size_t kstep = (size_t)(BK * 2);
    const size_t hstep = (size_t)HALF * K * 2;
    const size_t tstep = 2 * hstep;
    const unsigned ldsw = (unsigned)wid * 1024u;
    const int aoff = lds_byte(wr * 64 + fr, fq * 8), boff = lds_byte(wc * 32 + fr, fq * 8);
#define PG8_SA(b, h) (((b) * 2 + (h)) * HTB)
#define PG8_SB(b, h) ((4 + (b) * 2 + (h)) * HTB)
#define PG8_STAGE(bufoff, gbase, voff) do { _Pragma("unroll") for (int _i = 0; _i < 2; ++_i) \
        __builtin_amdgcn_global_load_lds((const unsigned*)((const char*)(gbase) + (voff)[_i]), (PG8_LAS unsigned*)(lds + (bufoff) + ldsw + _i * 8192), 16, 0, 0); } while (0)
#define PG8_LDA(dst, b, h) do { _Pragma("unroll") for (int m = 0; m < 4; ++m) _Pragma("unroll") for (int k = 0; k < 2; ++k) dst[m][k] = *(const PG8_LAS bf16x8*)(lds + PG8_SA(b, h) + aoff + m * 2048 + k * 1024); } while (0)
#define PG8_LDB(dst, b, h) do { _Pragma("unroll") for (int n = 0; n < 2; ++n) _Pragma("unroll") for (int k = 0; k < 2; ++k) dst[n][k] = *(const PG8_LAS bf16x8*)(lds + PG8_SB(b, h) + boff + n * 2048 + k * 1024); } while (0)
#define PG8_MMA(ai, bj, At, Bt) do { __builtin_amdgcn_s_setprio(1); _Pragma("unroll") for (int m = 0; m < 4; ++m) _Pragma("unroll") for (int n = 0; n < 2; ++n) _Pragma("unroll") for (int k = 0; k < 2; ++k) \
        acc[ai][bj][m][n] = __builtin_amdgcn_mfma_f32_16x16x32_bf16(Bt[n][k], At[m][k], acc[ai][bj][m][n], 0, 0, 0); __builtin_amdgcn_s_setprio(0); } while (0)
#define PG8_WAIT_V(n) asm volatile("s_waitcnt vmcnt(" #n ")" ::: "memory")
#define PG8_WAIT_L(n) asm volatile("s_waitcnt lgkmcnt(" #n ")" ::: "memory")
#define PG8_BAR __builtin_amdgcn_s_barrier()
#define PG8_SCHED __builtin_amdgcn_sched_barrier(0)
    Unit cur, nxt; int ui = 0;
    if (!S.next(0, cur)) return;
    f32x4 acc[2][2][4][2];
#pragma unroll
    for (int a = 0; a < 2; ++a)
#pragma unroll
        for (int b = 0; b < 2; ++b)
#pragma unroll
            for (int m = 0; m < 4; ++m)
#pragma unroll
                for (int n = 0; n < 2; ++n) acc[a][b][m][n] = (f32x4){0.f, 0.f, 0.f, 0.f};
    bf16x8 At[4][2], B0[2][2], B1[2][2];
    const char* cA = (const char*)g.A + (size_t)cur.pm * tstep; const char* cB = (const char*)g.Bt + (size_t)cur.pn * tstep;
    S.a_ready(cur);
    if constexpr (SP2) {
        PG8_STAGE(PG8_SB(0, 0), cB, voffB); PG8_STAGE(PG8_SB(0, 1), cB + hstep, voffB); PG8_STAGE(PG8_SA(0, 0), cA, voffA); PG8_STAGE(PG8_SA(0, 1), cA + hstep, voffA);
        if (wr == 1) PG8_BAR;
        PG8_WAIT_V(2); PG8_BAR;
        PG8_STAGE(PG8_SB(1, 0), cB + kstep, voffB); PG8_STAGE(PG8_SA(1, 0), cA + kstep, voffA); PG8_STAGE(PG8_SB(1, 1), cB + hstep + kstep, voffB);
        PG8_WAIT_V(6); PG8_BAR;
    } else {
        PG8_STAGE(PG8_SB(0, 0), cB, voffB); PG8_STAGE(PG8_SA(0, 0), cA, voffA); PG8_STAGE(PG8_SB(0, 1), cB + hstep, voffB); PG8_STAGE(PG8_SA(0, 1), cA + hstep, voffA);
        if (wr == 1) PG8_BAR;
        PG8_WAIT_V(4); PG8_BAR;
        PG8_STAGE(PG8_SB(1, 0), cB + kstep, voffB); PG8_STAGE(PG8_SA(1, 0), cA + kstep, voffA); PG8_STAGE(PG8_SB(1, 1), cB + hstep + kstep, voffB);
        PG8_WAIT_V(6); PG8_BAR;
    }
    for (;;) {
        const bool has_next = S.next(ui + 1, nxt);
        const char* nA = has_next ? (const char*)g.A + (size_t)nxt.pm * tstep : cA; const char* nB = has_next ? (const char*)g.Bt + (size_t)nxt.pn * tstep : cB;
        for (int t = 0; t < nt; t += 2) {
            const bool last = (t == nt - 2);
            const char* a1 = cA + (size_t)(t + 1) * kstep;
            const char* a2 = last ? nA : cA + (size_t)(t + 2) * kstep; const char* b2 = last ? nB : cB + (size_t)(t + 2) * kstep;
            const char* a3 = a2 + kstep; const char* b3 = b2 + kstep;
            if (last && has_next) S.a_ready(nxt);
            if constexpr (SP2) {
            PG8_LDB(B0, 0, 0); PG8_LDB(B1, 0, 1); PG8_SCHED; PG8_LDA(At, 0, 0); PG8_STAGE(PG8_SA(1, 1), a1 + hstep, voffA);
            PG8_WAIT_V(8); PG8_WAIT_L(0); PG8_BAR; PG8_MMA(0, 0, At, B0); PG8_MMA(0, 1, At, B1); PG8_BAR; PG8_SCHED;
            PG8_LDA(At, 0, 1); PG8_STAGE(PG8_SB(0, 0), b2, voffB); PG8_STAGE(PG8_SB(0, 1), b2 + hstep, voffB); PG8_STAGE(PG8_SA(0, 0), a2, voffA);
            PG8_WAIT_V(8); PG8_WAIT_L(0); PG8_BAR; PG8_MMA(1, 0, At, B0); PG8_MMA(1, 1, At, B1); PG8_BAR; PG8_SCHED;
            PG8_LDB(B0, 1, 0); PG8_LDB(B1, 1, 1); PG8_SCHED; PG8_LDA(At, 1, 0); PG8_STAGE(PG8_SA(0, 1), a2 + hstep, voffA);
            PG8_WAIT_V(8); PG8_WAIT_L(0); PG8_BAR; PG8_MMA(0, 0, At, B0); PG8_MMA(0, 1, At, B1); PG8_BAR; PG8_SCHED;
            PG8_LDA(At, 1, 1); PG8_STAGE(PG8_SB(1, 0), b3, voffB); PG8_STAGE(PG8_SB(1, 1), b3 + hstep, voffB); PG8_STAGE(PG8_SA(1, 0), a3, voffA);
            PG8_WAIT_V(8); PG8_WAIT_L(0); PG8_BAR; PG8_MMA(1, 0, At, B0); PG8_MMA(1, 1, At, B1); PG8_BAR; PG8_SCHED;
            } else {
            PG8_LDB(B0, 0, 0); PG8_SCHED; PG8_LDA(At, 0, 0); PG8_STAGE(PG8_SA(1, 1), a1 + hstep, voffA);
            PG8_WAIT_L(8); PG8_BAR; PG8_WAIT_L(0); PG8_MMA(0, 0, At, B0); PG8_BAR; PG8_SCHED;
            PG8_LDB(B1, 0, 1); PG8_STAGE(PG8_SB(0, 0), b2, voffB);
            PG8_BAR; PG8_WAIT_L(0); PG8_MMA(0, 1, At, B1); PG8_BAR;
            PG8_LDA(At, 0, 1); PG8_STAGE(PG8_SA(0, 0), a2, voffA);
            PG8_BAR; PG8_WAIT_L(0); PG8_MMA(1, 0, At, B0); PG8_BAR; PG8_SCHED;
            PG8_STAGE(PG8_SB(0, 1), b2 + hstep, voffB);
            PG8_WAIT_V(6); PG8_BAR; PG8_MMA(1, 1, At, B1); PG8_BAR;
            PG8_LDB(B0, 1, 0); PG8_SCHED; PG8_LDA(At, 1, 0); PG8_STAGE(PG8_SA(0, 1), a2 + hstep, voffA);
            PG8_WAIT_L(8); PG8_BAR; PG8_WAIT_L(0); PG8_MMA(0, 0, At, B0); PG8_BAR; PG8_SCHED;
            PG8_LDB(B1, 1, 1); PG8_STAGE(PG8_SB(1, 0), b3, voffB);
            PG8_BAR; PG8_WAIT_L(0); PG8_MMA(0, 1, At, B1); PG8_BAR;
            PG8_LDA(At, 1, 1); PG8_STAGE(PG8_SA(1, 0), a3, voffA);
            PG8_BAR; PG8_WAIT_L(0); PG8_MMA(1, 0, At, B0); PG8_BAR; PG8_SCHED;
            PG8_STAGE(PG8_SB(1, 1), b3 + hstep, voffB);
            PG8_WAIT_V(6); PG8_BAR; PG8_MMA(1, 1, At, B1); PG8_BAR;
            }
        }
        if constexpr (ALIGN_EPI) { if (wr == 0) PG8_BAR; }
        if constexpr (!Epi::AFTER_DRAIN) { E(acc, cur, wr, wc, fr, fq); S.done(cur); }
        if (!has_next) break;
#pragma unroll
        for (int a = 0; a < 2; ++a)
#pragma unroll
            for (int b = 0; b < 2; ++b)
#pragma unroll
                for (int m = 0; m < 4; ++m)
#pragma unroll
                    for (int n = 0; n < 2; ++n) acc[a][b][m][n] = (f32x4){0.f, 0.f, 0.f, 0.f};
        cur = nxt; cA = nA; cB = nB; ++ui;
        if constexpr (ALIGN_EPI) { if (wr == 1) PG8_BAR; }
    }
    PG8_WAIT_V(0);
    if constexpr (!ALIGN_EPI) { if (wr == 0) PG8_BAR; }
    PG8_BAR;
    if constexpr (Epi::AFTER_DRAIN) { E.fused(acc, cur, wr, wc, fr, fq, lds, wid, lane); S.done(cur); }
#undef PG8_SA
#undef PG8_SB
#undef PG8_STAGE
#undef PG8_LDA
#undef PG8_LDB
#undef PG8_MMA
#undef PG8_WAIT_V
#undef PG8_WAIT_L
#undef PG8_BAR
#undef PG8_SCHED
}
}

#ifndef PG8_SP2
#define PG8_SP2 true
#endif
#ifndef PG8_ALIGN
#define PG8_ALIGN true
#endif
namespace pg8 {
struct EpiF32 {
    static constexpr bool PERM = false, AFTER_DRAIN = false;
    float* O; int ldc;
    __device__ __forceinline__ void operator()(const f32x4 (&acc)[2][2][4][2], const Unit& u, int wr, int wc, int fr, int fq) const {
        const int col0 = u.pn * BM + wc * 32 + 4 * fq;
#pragma unroll
        for (int ai = 0; ai < 2; ++ai)
#pragma unroll
            for (int m = 0; m < 4; ++m) { float* rowp = O + (size_t)(u.pm * BM + ai * HALF + wr * 64 + m * 16 + fr) * ldc + col0;
#pragma unroll
                for (int bj = 0; bj < 2; ++bj)
#pragma unroll
                    for (int n = 0; n < 2; ++n) *(f32x4*)(rowp + bj * HALF + n * 16) = acc[ai][bj][m][n]; }
    }
};
}


namespace attn_body {
using bf16=__hip_bfloat16;
using bf16x8=__attribute__((ext_vector_type(8)))short;
using s16x4=__attribute__((ext_vector_type(4)))short;
using f32x16=__attribute__((ext_vector_type(16)))float;
using u32x4=__attribute__((ext_vector_type(4)))unsigned;
constexpr int BATCH=4,NHEAD=16,SEQ=4096,D=64,DM=NHEAD*D;
constexpr int NW=8,QBLK=32,QB=QBLK*NW,KVBLK=64,NQB=SEQ/QB;
constexpr int ATTN_PITCH=DM, ATTN_UNIT_ROWS=QB;
__device__ __forceinline__ int crow(int r,int hi){return (r&3)+8*(r>>2)+4*hi;}
#define SBAR() __builtin_amdgcn_sched_barrier(0)
__device__ __forceinline__ void cmask(f32x16&p0,f32x16&p1,int jb,int qrel,int hi){
  const float NEG=-INFINITY; int kb=64*jb+4*hi;
  #pragma unroll
  for(int r=0;r<16;++r){int kv=kb+(r&3)+8*(r>>2); if(kv>qrel)p0[r]=NEG; if(kv+32>qrel)p1[r]=NEG;}
}

constexpr int NSLOT=3, SLOTB=8192;
constexpr int LDS_K=0, LDS_V=NSLOT*SLOTB, LDS_WS=2*NSLOT*SLOTB, LDS_OST=LDS_WS+NW*64*4, LDS_BI=LDS_OST+NW*4096, SLOTBI=2048, LDS_BYTES=LDS_BI+NSLOT*SLOTBI;
constexpr float C2=0.125f*1.4426950408889634f;
__device__ __forceinline__ void glds16(const void*gsrc,unsigned lds_dst){unsigned keep;
  asm volatile("s_mov_b32 %0, m0\n\ts_mov_b32 m0, %2\n\ts_nop 0\n\tglobal_load_lds_dwordx4 %1, off\n\ts_mov_b32 m0, %0":"=&s"(keep):"v"(gsrc),"s"(lds_dst):"memory");}
__device__ __forceinline__ void glds4(const void*gsrc,unsigned lds_dst){unsigned keep;
  asm volatile("s_mov_b32 %0, m0\n\ts_mov_b32 m0, %2\n\ts_nop 0\n\tglobal_load_lds_dword %1, off\n\ts_mov_b32 m0, %0":"=&s"(keep):"v"(gsrc),"s"(lds_dst):"memory");}
__device__ __forceinline__ float max3f(float a,float b,float c){float r;asm("v_max3_f32 %0, %1, %2, %3":"=v"(r):"v"(a),"v"(b),"v"(c));return r;}
__device__ __forceinline__ float max2f(float a,float b){float r;asm("v_max_f32_e32 %0, %1, %2":"=v"(r):"v"(a),"v"(b));return r;}
__device__ __forceinline__ float fadd_s(float a,float b){float r;asm("v_add_f32_e32 %0, %1, %2":"=v"(r):"v"(a),"v"(b));return r;}
__device__ __forceinline__ float fsub_s(float a,float b){float r;asm("v_sub_f32_e32 %0, %1, %2":"=v"(r):"v"(a),"v"(b));return r;}
typedef float f32x2_t __attribute__((ext_vector_type(2))); typedef __bf16 bf16x2_t __attribute__((ext_vector_type(2)));
__device__ __forceinline__ unsigned cvtpk_s(float lo,float hi){f32x2_t v={lo,hi};bf16x2_t b=__builtin_convertvector(v,bf16x2_t);return __builtin_bit_cast(unsigned,b);}
#define WAIT_BAR(N) asm volatile("s_waitcnt vmcnt(" #N ") lgkmcnt(0)\n\ts_barrier":::"memory")

template<bool BIAS> __device__ __forceinline__ void qkt(f32x16&p0,f32x16&p1,const char*Kslot,const bf16x8*qr,const f32x16&negm,int r32,int hi,bf16x8 kb0,bf16x8 kb1,bf16x8 qones){
  const char*kb=Kslot+hi*1024+r32*16;
  #pragma unroll
  for(int d0=0;d0<4;++d0){
    const bf16x8 b0=*reinterpret_cast<const bf16x8*>(kb+d0*2048);
    const bf16x8 b1=*reinterpret_cast<const bf16x8*>(kb+d0*2048+512);
    if(d0==0){ if(BIAS){const f32x16 z=f32x16{};p0=__builtin_amdgcn_mfma_f32_32x32x16_bf16(b0,qr[0],z,0,0,0);p1=__builtin_amdgcn_mfma_f32_32x32x16_bf16(b1,qr[0],z,0,0,0);}
      else{p0=__builtin_amdgcn_mfma_f32_32x32x16_bf16(b0,qr[0],negm,0,0,0);p1=__builtin_amdgcn_mfma_f32_32x32x16_bf16(b1,qr[0],negm,0,0,0);} }
    else{p0=__builtin_amdgcn_mfma_f32_32x32x16_bf16(b0,qr[d0],p0,0,0,0);p1=__builtin_amdgcn_mfma_f32_32x32x16_bf16(b1,qr[d0],p1,0,0,0);}}
  if(BIAS){p0=__builtin_amdgcn_mfma_f32_32x32x16_bf16(kb0,qones,p0,0,0,0);p1=__builtin_amdgcn_mfma_f32_32x32x16_bf16(kb1,qones,p1,0,0,0);}
}
typedef __attribute__((address_space(3))) const char* lds_cptr;
typedef short v4i16_t __attribute__((ext_vector_type(4)));
__device__ __forceinline__ void kload8(bf16x8*kf,lds_cptr kp){
  kf[0]=*(const __attribute__((address_space(3))) bf16x8*)(kp);      kf[1]=*(const __attribute__((address_space(3))) bf16x8*)(kp+512);
  kf[2]=*(const __attribute__((address_space(3))) bf16x8*)(kp+2048); kf[3]=*(const __attribute__((address_space(3))) bf16x8*)(kp+2560);
  kf[4]=*(const __attribute__((address_space(3))) bf16x8*)(kp+4096); kf[5]=*(const __attribute__((address_space(3))) bf16x8*)(kp+4608);
  kf[6]=*(const __attribute__((address_space(3))) bf16x8*)(kp+6144); kf[7]=*(const __attribute__((address_space(3))) bf16x8*)(kp+6656);
}
__device__ __forceinline__ void kload2(bf16x8*kf,lds_cptr kp,int j){ kf[2*j]=*(const __attribute__((address_space(3))) bf16x8*)(kp+j*2048); kf[2*j+1]=*(const __attribute__((address_space(3))) bf16x8*)(kp+j*2048+512); }
__device__ __forceinline__ s16x4 vtr(lds_cptr p){ return __builtin_bit_cast(s16x4,__builtin_amdgcn_ds_read_tr16_b64_v4i16((__attribute__((address_space(3))) v4i16_t*)p)); }
__device__ __forceinline__ float rowmax(const f32x16&p0,const f32x16&p1){
  float a=max3f(p0[0],p0[1],p1[0]),b=max3f(p0[2],p0[3],p1[1]);a=max3f(a,p1[2],p1[3]);
  #pragma unroll
  for(int r=4;r<16;r+=4){a=max3f(a,p0[r],p0[r+1]);b=max3f(b,p0[r+2],p0[r+3]);a=max3f(a,p1[r],p1[r+1]);b=max3f(b,p1[r+2],p1[r+3]);}
  const float m=max2f(a,b);
  auto rr=__builtin_amdgcn_permlane32_swap(__float_as_uint(m),__float_as_uint(m),false,false);
  return max2f(__uint_as_float(rr[0]),__uint_as_float(rr[1]));
}
__device__ __forceinline__ void pv(f32x16*o,int vb,bf16x8 pa0,bf16x8 pa1,bf16x8 pa2,bf16x8 pa3){
  #pragma unroll
  for(int d0=0;d0<2;++d0){s16x4 lo[4],hi[4];
    #pragma unroll
    for(int ks=0;ks<4;++ks){
      asm volatile("ds_read_b64_tr_b16 %0,%1 offset:%c2":"=&v"(lo[ks]):"v"(vb),"i"(d0*4096+ks*1024):"memory");
      asm volatile("ds_read_b64_tr_b16 %0,%1 offset:%c2":"=&v"(hi[ks]):"v"(vb),"i"(d0*4096+ks*1024+512):"memory");}
    asm volatile("s_waitcnt lgkmcnt(0)":::"memory");SBAR();
    #define PK(k) (bf16x8){lo[k][0],lo[k][1],lo[k][2],lo[k][3],hi[k][0],hi[k][1],hi[k][2],hi[k][3]}
    o[d0]=__builtin_amdgcn_mfma_f32_32x32x16_bf16(pa0,PK(0),o[d0],0,0,0);
    o[d0]=__builtin_amdgcn_mfma_f32_32x32x16_bf16(pa1,PK(1),o[d0],0,0,0);
    o[d0]=__builtin_amdgcn_mfma_f32_32x32x16_bf16(pa2,PK(2),o[d0],0,0,0);
    o[d0]=__builtin_amdgcn_mfma_f32_32x32x16_bf16(pa3,PK(3),o[d0],0,0,0);
    #undef PK
  }
}

#ifndef ATTN_STORE16
#define ATTN_STORE16(p,v) (*(u32x4*)(p)=(v))
#endif
template<int THRL,bool BIAS> __device__ __forceinline__ void attn_unit(int b,int h,int qb,const bf16*Q,const bf16*__restrict__ K,const bf16*__restrict__ V,bf16*O,char*shm,const unsigned char*BT){
  int tid_=threadIdx.x; asm volatile("":"+v"(tid_));
  const int tid=tid_,lane=tid&63,r32=lane&31,hi=lane>>5; const int wid=__builtin_amdgcn_readfirstlane(tid>>6);
  const long rowbase=(long)b*SEQ; const int q0=qb*QB;
  const bf16*Qw=Q+(rowbase+q0+wid*QBLK)*DM+h*D;
  const bf16*Kh=K+rowbase*DM+h*D,*Vh=V+rowbase*DM+h*D;
  const unsigned lds0=(unsigned)(uintptr_t)shm;
  float*wsf=(float*)(shm+LDS_WS)+wid*64;
  const bf16*ksrc=Kh+(long)lane*DM+wid*8;
  const bf16*vsrc=Vh+(long)(16*(wid&3)+(lane>>2))*DM+(wid>>2)*32+(lane&3)*8;
  const unsigned kdst=lds0+LDS_K+wid*1024, vdst=lds0+LDS_V+wid*1024;
  #define DMA_K(t,slot) glds16(ksrc+(long)(t)*KVBLK*DM,(unsigned)__builtin_amdgcn_readfirstlane(kdst+(slot)))
  #define DMA_V(t,slot) glds16(vsrc+(long)(t)*KVBLK*DM,(unsigned)__builtin_amdgcn_readfirstlane(vdst+(slot)))
  const unsigned char*bsrc=BT+((long)(b*NHEAD+h)*SEQ)*32+wid*256+lane*4; const unsigned bdst=lds0+LDS_BI+wid*256;
  #define DMA_B(t,slot) glds4(bsrc+(long)(t)*2048,(unsigned)__builtin_amdgcn_readfirstlane(bdst+((slot)>>2)))
  const lds_cptr bp0=(lds_cptr)shm+LDS_BI+r32*32+hi*16; bf16x8 kb0=bf16x8{},kb1=bf16x8{}; u32x4 qm={0x3F803F80u,0x00003F80u,0u,0u};
  #define qones __builtin_bit_cast(bf16x8,qm)
  #define SETREF() do{ if(BIAS){ const float nm_=-mhat; const unsigned h_=__float_as_uint(nm_)&0xffff0000u; const float r1_=nm_-__uint_as_float(h_); const unsigned m_=__float_as_uint(r1_)&0xffff0000u; const float r2_=r1_-__uint_as_float(m_); \
      qm[1]=0x3F80u|h_; qm[2]=(m_>>16)|(__float_as_uint(r2_)&0xffff0000u); } else { _Pragma("unroll") for(int r=0;r<16;++r)negm[r]=-mhat; asm volatile("":"+v"(negm)); } }while(0)
  #define BLD(slot) do{ if(BIAS){ kb0=*(const __attribute__((address_space(3))) bf16x8*)(bp0+((slot)>>2)); kb1=*(const __attribute__((address_space(3))) bf16x8*)(bp0+((slot)>>2)+1024); } }while(0)
  const int vb0=(int)(lds0+LDS_V)+((lane>>4)&1)*32+(lane&3)*8+(4*hi+((lane&15)>>2))*64;
  const char*Kbase=shm+LDS_K; bf16x8 kf[8];
  const lds_cptr shm3=(lds_cptr)shm; const lds_cptr kp0=shm3+LDS_K+hi*1024+r32*16; const lds_cptr vp0=shm3+LDS_V+((lane>>4)&1)*32+(lane&3)*8+(4*hi+((lane&15)>>2))*64;
  const int NT=(q0+QB)/KVBLK;
  DMA_K(0,0);if(BIAS){DMA_B(0,0);}DMA_V(0,0);DMA_K(1,SLOTB);if(BIAS){DMA_B(1,SLOTB);}
  bf16x8 qr[4];
  #pragma unroll
  for(int d0=0;d0<4;++d0)qr[d0]=*reinterpret_cast<const bf16x8*>(&Qw[(long)r32*DM+d0*16+hi*8]);
  float mhat=0.f,l_reg=0.f;f32x16 o[2];o[0]=f32x16{};o[1]=f32x16{};f32x16 negm=f32x16{}; if(!BIAS){asm volatile("":"+v"(negm));}
  const int qrel=wid*QBLK+r32;
  #define CMASK(P0,P1,t) do{int jb_=(t)-(NT-4); if(jb_>=0)cmask(P0,P1,jb_,qrel,hi);}while(0)
  bool resc=false;
  #define START(P0,P1) do{ const float rm=rowmax(P0,P1); resc=false; \
    { const float dl=rm; mhat=fadd_s(mhat,dl); \
      _Pragma("unroll") for(int r=0;r<16;++r){P0[r]=fsub_s(P0[r],dl);P1[r]=fsub_s(P1[r],dl);} \
      SETREF(); } \
    _Pragma("unroll") for(int r=0;r<16;++r)P0[r]=__builtin_amdgcn_exp2f(P0[r]); }while(0)
  #define RESC() do{ if(resc){ asm volatile("s_waitcnt lgkmcnt(0)":::"memory"); \
      _Pragma("unroll") for(int d_=0;d_<2;++d_) _Pragma("unroll") for(int r=0;r<16;++r)o[d_][r]*=wsf[crow(r,hi)]; } }while(0)
  f32x16 pA0,pA1,pB0,pB1;
  int sl_prev=0,sl_cur=0,sl_next=SLOTB;
  #define ROT() do{sl_prev=sl_cur;sl_cur=sl_next;sl_next=(sl_next==(NSLOT-1)*SLOTB)?0:sl_next+SLOTB;}while(0)
  DMA_K(2,2*SLOTB);
  if(BIAS){WAIT_BAR(4);}else{WAIT_BAR(3);}
  if(BIAS){DMA_B(2,2*SLOTB);BLD(0);}
  qkt<BIAS>(pA0,pA1,Kbase,qr,negm,r32,hi,kb0,kb1,qones);asm volatile("s_nop 15\n\ts_nop 7":"+v"(pA0),"+v"(pA1));CMASK(pA0,pA1,0);
  START(pA0,pA1);
  _Pragma("unroll") for(int r=0;r<16;++r)pA1[r]=__builtin_amdgcn_exp2f(pA1[r]);
  WAIT_BAR(0);
  DMA_K(3,0);DMA_V(1,SLOTB);
  ROT();
  kload8(kf,kp0+sl_cur);
  WAIT_BAR(2);
  s16x4 vlo[8],vhi[8]; u32x4 pw0,pw1,pw2,pw3;
  #define PKW(P,B) cvtpk_s(P[B],P[B+1])
  #define PAF(k) __builtin_bit_cast(bf16x8,pw##k)
  #define VFR(i) (bf16x8){vlo[i][0],vlo[i][1],vlo[i][2],vlo[i][3],vhi[i][0],vhi[i][1],vhi[i][2],vhi[i][3]}
  #define PIN(x) asm volatile("":"+v"(x))
  #define MX3(a,b,c) __builtin_fmaxf(__builtin_fmaxf((a),(b)),(c))
  #define GAPA(MF,A0,A1,A2,A3,W0,W1,PW) do{ MF; sacc+=A0; sacc+=A1; sacc+=A2; sacc+=A3; PIN(sacc); W0; W1; PIN(PW); SBAR(); }while(0)
  #define EX(v) __builtin_amdgcn_exp2f(v)
  #define GAPB(MF,X,B) do{ MF; X[B]=EX(X[B]); X[B+1]=EX(X[B+1]); X[B+2]=EX(X[B+2]); X[B+3]=EX(X[B+3]); PIN(X); SBAR(); }while(0)
  #define VRD(i) do{ vlo[i]=vtr(vp_+(((i)>>2)*4096+((i)&3)*1024)); vhi[i]=vtr(vp_+(((i)>>2)*4096+((i)&3)*1024+512)); }while(0)
  #define KRD(G,j) do{ if(G){ kload2(kf,kp0+sl_next,j); SBAR(); } }while(0)
  #define CINIT (BIAS?f32x16{}:negm)
  #define STEP(C0,C1,P0,P1,t,GK,GV,GL,GB) do{ SBAR(); \
    if(BIAS){ if(GB){DMA_B((t)+2,sl_prev);} BLD(sl_cur); } \
    const lds_cptr vp_=vp0+sl_prev; \
    VRD(0); SBAR(); float sacc=(P0[0]+P0[1]); \
    GAPA(C0=__builtin_amdgcn_mfma_f32_32x32x16_bf16(kf[0],qr[0],CINIT,0,0,0), P0[2],P0[3],P0[4],P0[5],     pw0[0]=PKW(P0,0), pw0[1]=PKW(P0,2), pw0); \
    VRD(4); SBAR(); GAPA(C1=__builtin_amdgcn_mfma_f32_32x32x16_bf16(kf[1],qr[0],CINIT,0,0,0), P0[6],P0[7],P0[8],P0[9],     pw0[2]=PKW(P0,4), pw0[3]=PKW(P0,6), pw0); \
    VRD(1); SBAR(); GAPA(C0=__builtin_amdgcn_mfma_f32_32x32x16_bf16(kf[2],qr[1],C0,0,0,0),   P0[10],P0[11],P0[12],P0[13], pw1[0]=PKW(P0,8), pw1[1]=PKW(P0,10), pw1); \
    VRD(5); SBAR(); GAPA(C1=__builtin_amdgcn_mfma_f32_32x32x16_bf16(kf[3],qr[1],C1,0,0,0),   P0[14],P0[15],P1[0],P1[1],   pw1[2]=PKW(P0,12),pw1[3]=PKW(P0,14), pw1); \
    VRD(2); SBAR(); GAPA(C0=__builtin_amdgcn_mfma_f32_32x32x16_bf16(kf[4],qr[2],C0,0,0,0),   P1[2],P1[3],P1[4],P1[5],     pw2[0]=PKW(P1,0), pw2[1]=PKW(P1,2), pw2); \
    VRD(6); SBAR(); GAPA(C1=__builtin_amdgcn_mfma_f32_32x32x16_bf16(kf[5],qr[2],C1,0,0,0),   P1[6],P1[7],P1[8],P1[9],     pw2[2]=PKW(P1,4), pw2[3]=PKW(P1,6), pw2); \
    VRD(3); SBAR(); GAPA(C0=__builtin_amdgcn_mfma_f32_32x32x16_bf16(kf[6],qr[3],C0,0,0,0),   P1[10],P1[11],P1[12],P1[13], pw3[0]=PKW(P1,8), pw3[1]=PKW(P1,10), pw3); \
    VRD(7); SBAR(); GAPA(C1=__builtin_amdgcn_mfma_f32_32x32x16_bf16(kf[7],qr[3],C1,0,0,0),   P1[14],P1[15],0.f,0.f,       pw3[2]=PKW(P1,12),pw3[3]=PKW(P1,14), pw3); \
    if(BIAS){ C0=__builtin_amdgcn_mfma_f32_32x32x16_bf16(kb0,qones,C0,0,0,0); C1=__builtin_amdgcn_mfma_f32_32x32x16_bf16(kb1,qones,C1,0,0,0); } \
    l_reg+=sacc; \
    if(GK){DMA_K((t)+3,sl_cur);} if(GV){DMA_V((t)+1,sl_next);} \
    CMASK(C0,C1,t); \
    { float a=MX3(C0[0],C0[1],C1[0]),b=MX3(C0[2],C0[3],C1[1]); a=MX3(a,C1[2],C1[3]); \
      _Pragma("unroll") for(int r=4;r<16;r+=4){a=MX3(a,C0[r],C0[r+1]);b=MX3(b,C0[r+2],C0[r+3]);a=MX3(a,C1[r],C1[r+1]);b=MX3(b,C1[r+2],C1[r+3]);} \
      float rm=__builtin_fmaxf(a,b); { auto rr=__builtin_amdgcn_permlane32_swap(__float_as_uint(rm),__float_as_uint(rm),false,false); rm=__builtin_fmaxf(__uint_as_float(rr[0]),__uint_as_float(rr[1])); } \
      resc=false; \
      if(__builtin_expect(__any(rm>(float)THRL),0)){ const float dl=__builtin_fmaxf(rm,0.f); mhat+=dl; \
        _Pragma("unroll") for(int r=0;r<16;++r){C0[r]-=dl;C1[r]-=dl;} \
        SETREF(); \
        const float f=__builtin_amdgcn_exp2f(-dl); l_reg*=f; if(hi==0)wsf[r32]=f; resc=true; } } \
    SBAR(); \
    GAPB(o[0]=__builtin_amdgcn_mfma_f32_32x32x16_bf16(PAF(0),VFR(0),o[0],0,0,0), C0,0); \
    GAPB(o[1]=__builtin_amdgcn_mfma_f32_32x32x16_bf16(PAF(0),VFR(4),o[1],0,0,0), C0,4); \
    KRD(GL,0); GAPB(o[0]=__builtin_amdgcn_mfma_f32_32x32x16_bf16(PAF(1),VFR(1),o[0],0,0,0), C0,8); \
    KRD(GL,1); GAPB(o[1]=__builtin_amdgcn_mfma_f32_32x32x16_bf16(PAF(1),VFR(5),o[1],0,0,0), C0,12); \
    KRD(GL,2); GAPB(o[0]=__builtin_amdgcn_mfma_f32_32x32x16_bf16(PAF(2),VFR(2),o[0],0,0,0), C1,0); \
    KRD(GL,3); GAPB(o[1]=__builtin_amdgcn_mfma_f32_32x32x16_bf16(PAF(2),VFR(6),o[1],0,0,0), C1,4); \
    GAPB(o[0]=__builtin_amdgcn_mfma_f32_32x32x16_bf16(PAF(3),VFR(3),o[0],0,0,0), C1,8); \
    GAPB(o[1]=__builtin_amdgcn_mfma_f32_32x32x16_bf16(PAF(3),VFR(7),o[1],0,0,0), C1,12); \
    }while(0)
  int t=1;
  #undef CMASK
  #define CMASK(P0,P1,t) do{}while(0)
  for(;t+5<NT;t+=2){
    STEP(pB0,pB1,pA0,pA1,t,true,true,true,true);     WAIT_BAR(2); RESC(); ROT();
    STEP(pA0,pA1,pB0,pB1,t+1,true,true,true,true);   WAIT_BAR(2); RESC(); ROT();
  }
  #undef CMASK
  #define CMASK(P0,P1,t) do{int jb_=(t)-(NT-4); if(jb_>=0)cmask(P0,P1,jb_,qrel,hi);}while(0)
  #define ENDW(tt) do{ if((tt)+3<NT){WAIT_BAR(2);} else if((tt)+2<NT){WAIT_BAR(1);} else {WAIT_BAR(0);} }while(0)
  for(;t+1<NT;t+=2){
    STEP(pB0,pB1,pA0,pA1,t,(t+3<NT),(t+1<NT),(t+1<NT),(t+2<NT));       ENDW(t);   RESC(); ROT();
    STEP(pA0,pA1,pB0,pB1,t+1,(t+4<NT),(t+2<NT),(t+2<NT),(t+3<NT));     ENDW(t+1); RESC(); ROT();
  }
  STEP(pB0,pB1,pA0,pA1,NT-1,false,false,false,false); RESC();
  { float sacc=pB0[0]+pB0[1]; _Pragma("unroll") for(int r=2;r<16;++r)sacc+=pB0[r]; _Pragma("unroll") for(int r=0;r<16;++r)sacc+=pB1[r]; l_reg+=sacc;
    pw0=(u32x4){PKW(pB0,0),PKW(pB0,2),PKW(pB0,4),PKW(pB0,6)};pw1=(u32x4){PKW(pB0,8),PKW(pB0,10),PKW(pB0,12),PKW(pB0,14)};pw2=(u32x4){PKW(pB1,0),PKW(pB1,2),PKW(pB1,4),PKW(pB1,6)};pw3=(u32x4){PKW(pB1,8),PKW(pB1,10),PKW(pB1,12),PKW(pB1,14)};
    SBAR(); pv(o,vb0+sl_cur,PAF(0),PAF(1),PAF(2),PAF(3)); }
  #undef PKW
  #undef PAF
  #undef VFR
  #undef PIN
  #undef MX3
  #undef GAPA
  #undef GAPB
  #undef EX
  #undef VRD
  #undef KRD
  #undef STEP
  #undef ENDW
  {auto rr=__builtin_amdgcn_permlane32_swap(__float_as_uint(l_reg),__float_as_uint(l_reg),false,false);l_reg=__uint_as_float(rr[0])+__uint_as_float(rr[1]);}
  if(hi==0)wsf[32+r32]=l_reg;asm volatile("s_waitcnt lgkmcnt(0)":::"memory");
  float rli[16];
  #pragma unroll
  for(int r=0;r<16;++r)rli[r]=__builtin_amdgcn_rcpf(wsf[32+crow(r,hi)]);
  bf16*Ow=O+(rowbase+q0+wid*QBLK)*DM+h*D;
  { bf16*stg=(bf16*)(shm+LDS_OST)+wid*2048;
    #pragma unroll
    for(int r=0;r<16;++r){const int orow=crow(r,hi);
      #pragma unroll
      for(int d0=0;d0<2;++d0)stg[orow*64+d0*32+r32]=__float2bfloat16(o[d0][r]*rli[r]);}
    asm volatile("s_waitcnt lgkmcnt(0)":::"memory");
    #pragma unroll
    for(int i=0;i<4;++i){const int row=i*8+(lane>>3),ch=lane&7; const u32x4 v=*(const u32x4*)(stg+row*64+ch*8); ATTN_STORE16(Ow+(long)row*DM+ch*8,v);} }
  asm volatile("s_waitcnt lgkmcnt(0)\n\ts_barrier":::"memory");
  #undef DMA_K
  #undef DMA_V
  #undef DMA_B
  #undef BLD
  #undef qones
  #undef SETREF
  #undef CINIT
  #undef CMASK
  #undef START
  #undef RESC
  #undef ROT
}
constexpr int ATTN_LDS_BYTES=LDS_BYTES;
struct AttnTensors { const bf16* Q; const bf16* K; const bf16* V; bf16* O; };
struct AttnUnit { int bh; int qb; };
struct StaticOrder {
  int vcu;
  __device__ __forceinline__ explicit StaticOrder(int grid,int block):vcu((block%8)*(grid/8)+block/8){}
  __device__ __forceinline__ bool next(int i,AttnUnit&u)const{ if(i>=4)return false; const int s=vcu&3; u.bh=vcu>>2; u.qb=(i==0)?s:(i==1)?7-s:(i==2)?8+s:15-s; return true; }
  __device__ __forceinline__ void a_ready(const AttnUnit&)const{}
  __device__ __forceinline__ void done(const AttnUnit&)const{}
};
template<class Sched,int THRL,bool BIAS> __device__ __forceinline__ void attn_phase(char*lds,const AttnTensors&T,const Sched&S,const unsigned char*BT){
  AttnUnit u;
  for(int i=0;S.next(i,u);++i){ S.a_ready(u); attn_unit<THRL,BIAS>(u.bh/NHEAD,u.bh%NHEAD,u.qb,T.Q,T.K,T.V,T.O,lds,BT); S.done(u); }
}
#undef SBAR
#undef WAIT_BAR
}
#define GAS __attribute__((address_space(1)))
#define LAS __attribute__((address_space(3)))
typedef unsigned short bf16;
typedef unsigned v4u __attribute__((ext_vector_type(4)));
typedef float f32x4 __attribute__((ext_vector_type(4)));
typedef short bf16x8 __attribute__((ext_vector_type(8)));
typedef GAS unsigned gu32;
typedef GAS unsigned long long gu64;
#define RLX_AGENT __ATOMIC_RELAXED, __HIP_MEMORY_SCOPE_AGENT
#define LDS_WAIT() asm volatile("s_waitcnt lgkmcnt(0)" ::: "memory")
#define VM_WAIT() asm volatile("s_waitcnt vmcnt(0)" ::: "memory")
__device__ __forceinline__ unsigned long long rt() { return __builtin_amdgcn_s_memrealtime(); }
__device__ __forceinline__ unsigned f2bf(float f) { unsigned u = __builtin_bit_cast(unsigned, f); return (u + 0x7fffu + ((u >> 16) & 1u)) >> 16; }
__device__ __forceinline__ unsigned pk2(float lo, float hi) { return f2bf(lo) | (f2bf(hi) << 16); }

#define XB_TMO      128
#define XB_XCNT(j)  (256  + 64 * (j))
#define XB_XSUB(j)  (1280 + 64 * (j))
#define XB_XGEN(j)  (2304 + 64 * (j))
#define XB_TOP      3328
#define XB_TOPGEN   3392
#define XCD_BAR_WORDS 3456
#define XB_SPIN_CAP (1u << 18)

__device__ __forceinline__ unsigned xb_ld(unsigned* p)              { return __hip_atomic_load(p, __ATOMIC_RELAXED, __HIP_MEMORY_SCOPE_AGENT); }
__device__ __forceinline__ unsigned xb_add(unsigned* p, unsigned v) { return __hip_atomic_fetch_add(p, v, __ATOMIC_RELAXED, __HIP_MEMORY_SCOPE_AGENT); }
__device__ __forceinline__ unsigned xb_xcc_id() { return (unsigned)__builtin_amdgcn_s_getreg((3 << 11) | 20) & 0xFu; }
#define XB_SPIN(cond, bar) do { unsigned _sp = 0; while (cond) { __builtin_amdgcn_s_sleep(1); \
    if ((++_sp & 255u) == 0u) { if (xb_ld(&(bar)[XB_TMO])) break; if (_sp > XB_SPIN_CAP) { atomicAdd(&(bar)[XB_TMO], 1u); break; } } } } while (0)

struct XcdBarrier {
    unsigned* bar; unsigned x;
    volatile LAS unsigned* st;
};

__device__ __forceinline__ XcdBarrier xcd_barrier_post(unsigned* bar, volatile LAS unsigned* st) {
    XcdBarrier b; b.bar = bar; b.x = xb_xcc_id(); b.st = st;
    if (threadIdx.x == 0) (void)xb_add(&bar[XB_XCNT(b.x)], 1u);
    return b;
}
__device__ __forceinline__ void xcd_barrier_complete(unsigned* bar, unsigned x, unsigned& nloc, unsigned& nx) {
    const unsigned G = gridDim.x * gridDim.y * gridDim.z;
    unsigned sum, cnt, mine, sp = 0u;
    for (;;) {
        sum = 0u; cnt = 0u; mine = 0u;
#pragma unroll
        for (unsigned j = 0; j < 16; ++j) { const unsigned c = xb_ld(&bar[XB_XCNT(j)]); sum += c; cnt += (c > 0u) ? 1u : 0u; mine = (j == x) ? c : mine; }
        if (sum == G) break;
        __builtin_amdgcn_s_sleep(1);
        if ((++sp & 255u) == 0u) { if (xb_ld(&bar[XB_TMO])) break; if (sp > XB_SPIN_CAP) { atomicAdd(&bar[XB_TMO], 1u); break; } }
    }
    nloc = mine > 0u ? mine : 1u; nx = cnt > 0u ? cnt : 1u;
}

__device__ __forceinline__ void xcd_barrier(const XcdBarrier& b) {
    asm volatile("s_waitcnt vmcnt(0)" ::: "memory");
    __syncthreads();
    if (threadIdx.x == 0) {
        unsigned* bar = b.bar;
        __builtin_amdgcn_s_waitcnt(0);
        unsigned nloc = b.st[0], nx = b.st[1];
        if (nloc == 0u) { xcd_barrier_complete(bar, b.x, nloc, nx); b.st[0] = nloc; b.st[1] = nx; }
        const unsigned old = xb_add(&bar[XB_XSUB(b.x)], 1u);
        const unsigned gen = old / nloc;
        if (old + 1u == (gen + 1u) * nloc) {
            __builtin_amdgcn_fence(__ATOMIC_RELEASE, "agent");
            asm volatile("s_waitcnt vmcnt(0)" ::: "memory");
            const unsigned og = xb_add(&bar[XB_TOP], 1u);
            const unsigned tg = og / nx;
            if (og + 1u == (tg + 1u) * nx) xb_add(&bar[XB_TOPGEN], 1u);
            else XB_SPIN(xb_ld(&bar[XB_TOPGEN]) == tg, bar);
            __builtin_amdgcn_fence(__ATOMIC_ACQUIRE, "agent");
            xb_add(&bar[XB_XGEN(b.x)], 1u);
            asm volatile("s_waitcnt vmcnt(0)" ::: "memory");
        } else {
            XB_SPIN(xb_ld(&bar[XB_XGEN(b.x)]) == gen, bar);
            __builtin_amdgcn_fence(__ATOMIC_ACQUIRE, "agent");
            asm volatile("s_waitcnt vmcnt(0)" ::: "memory");
        }
    }
    __syncthreads();
}
constexpr int NWAVES = 8;
constexpr int BATCH = 4, SEQ = 4096, D = 1024, NH = 16, HD = 64, FF = 2816, FF2 = 2 * FF, DH2 = 8, DV = 128;
constexpr int M = BATCH * SEQ;
constexpr int AWIN_LD = 3 * D + NH;
constexpr float LN_EPS = 1e-5f, RMS_EPS = 1e-5f;
constexpr float DN_ALPHA = 1.4142135623730951f;
constexpr float LAMBDA_INIT = 0.35550906759096926f;
constexpr float C2 = 0.125f * 1.4426950408889634f;
constexpr float LOG2E = 1.4426950408889634f;

constexpr size_t MiB = 1u << 20;
constexpr size_t WS_CTL = 0, CTL_ZERO_BYTES = 1 * MiB;
constexpr size_t WS_COS = 1 * MiB, WS_SIN = WS_COS + 512 * 1024;
constexpr size_t WS_FLOG = 2 * MiB;
constexpr size_t WS_CK = 3 * MiB;
constexpr size_t WS_X = 5 * MiB;
constexpr size_t WS_WQKV0 = 8 * MiB, WS_WO0 = 14 * MiB, WS_WQKV1 = 16 * MiB, WS_WO1 = 22 * MiB;
constexpr size_t WS_WIN0 = 24 * MiB, WS_WIN1 = 35 * MiB, WS_WOUT0 = 46 * MiB, WS_WOUT1 = 52 * MiB;
constexpr size_t WS_XB = 58 * MiB;
constexpr size_t WS_QO = 90 * MiB, WS_KB = 122 * MiB, WS_VB = 154 * MiB;
constexpr size_t WS_BT = 186 * MiB;
constexpr size_t WS_HS = 186 * MiB;
constexpr size_t WS_UH = 90 * MiB;
constexpr size_t WS_HH = 178 * MiB;
constexpr size_t WS_HSH = 222 * MiB;
constexpr size_t WS_END = 256 * MiB;
static_assert(WS_UH + (size_t)(M / 2) * FF2 * 2 <= WS_HH && WS_HH + (size_t)(M / 2) * FF * 2 <= WS_HSH && WS_HSH + (size_t)(M / 2) * D * 4 <= WS_END, "ffn map");
static_assert(WS_HS + (size_t)M * D * 4 <= WS_END && WS_VB + (size_t)M * D * 2 <= WS_HS && WS_XB + (size_t)M * D * 2 <= WS_QO, "attn map");
constexpr int CW_TMO = 0, CW_CODE = 1, CW_BAR = 4096, CW_SEAM = 16384, SEAM_BANK = 128 * 64;

constexpr int RING_OFF = 0, RING_BYTES = 131072;
constexpr int LDSCTL_OFF = RING_BYTES, MISC_OFF = LDSCTL_OFF + 320;
constexpr int LDS_BYTES = 147456;

struct Frame {
    LAS unsigned char* lds;
    volatile LAS unsigned* MISC;
    gu32* ctl;
    int tid, lane, wave;
    int vcu, G;
};
struct Args { const float* in[17]; float* out; unsigned char* ws; int ph_lo, ph_hi; };

__device__ __forceinline__ float wave_sum(float v) {
#pragma unroll
    for (int o = 1; o < 64; o <<= 1) v += __shfl_xor(v, o);
    return v;
}
__device__ __forceinline__ float bf2f(unsigned short h) { return __uint_as_float((unsigned)h << 16); }

__device__ __forceinline__ int map_row(int mode, int off, int n) {
    if (mode == 1) {
        const int g = n & ~63, d = n & 63;
        const int p = d < 32 ? 8 * (d >> 2) + (d & 3) : 8 * ((d - 32) >> 2) + 4 + (d & 3);
        return off + g + p;
    }
    if (mode == 2) {
        return n < FF ? 256 * (n >> 7) + (n & 127) : 256 * ((n - FF) >> 7) + 128 + ((n - FF) & 127);
    }
    return off + n;
}
__device__ __forceinline__ void p0_transpose_item(const float* W, int ldw, int K, int nblk, bf16* WT, int mode, int off, LAS float* scr, int item, int lane) {
    const int kb = item / nblk, nb = item % nblk, k0 = 64 * kb, n0 = 32 * nb;
#pragma unroll 8
    for (int i = 0; i < 32; ++i) { const int kk = 2 * i + (lane >> 5); scr[kk * 33 + (lane & 31)] = W[(size_t)(k0 + kk) * ldw + n0 + (lane & 31)]; }
    LDS_WAIT(); asm volatile("" ::: "memory");
    const int c = lane & 7;
#pragma unroll
    for (int j = 0; j < 4; ++j) { const int n = (lane >> 3) + 8 * j; const LAS float* s = scr + (8 * c) * 33 + n;
        v4u o; o.x = pk2(s[0 * 33], s[1 * 33]); o.y = pk2(s[2 * 33], s[3 * 33]); o.z = pk2(s[4 * 33], s[5 * 33]); o.w = pk2(s[6 * 33], s[7 * 33]);
        *(GAS v4u*)(WT + (size_t)map_row(mode, off, n0 + n) * K + k0 + 8 * c) = o; }
    LDS_WAIT(); asm volatile("" ::: "memory");
}
__device__ __forceinline__ void sincos_d(double x, double& s, double& c) {
    const double n = __builtin_rint(x * 0.63661977236758134308);
    double r = __builtin_fma(-n, 1.57079632679489655800, x); r = __builtin_fma(-n, 6.12323399573676603587e-17, r);
    const double r2 = r * r;
    double sp = -7.6471637318198164759e-13; sp = __builtin_fma(sp, r2, 1.6059043836821614599e-10); sp = __builtin_fma(sp, r2, -2.5052108385441718775e-08);
    sp = __builtin_fma(sp, r2, 2.7557319223985890653e-06); sp = __builtin_fma(sp, r2, -1.9841269841269841270e-04); sp = __builtin_fma(sp, r2, 8.3333333333333333333e-03);
    sp = __builtin_fma(sp, r2, -1.6666666666666666667e-01); const double sr = __builtin_fma(sp * r2, r, r);
    double cp = 4.7794773323873852974e-14; cp = __builtin_fma(cp, r2, -1.1470745597729724714e-11); cp = __builtin_fma(cp, r2, 2.0876756987868098979e-09);
    cp = __builtin_fma(cp, r2, -2.7557319223985890653e-07); cp = __builtin_fma(cp, r2, 2.4801587301587301587e-05); cp = __builtin_fma(cp, r2, -1.3888888888888888889e-03);
    cp = __builtin_fma(cp, r2, 4.1666666666666666667e-02); cp = __builtin_fma(cp, r2, -0.5); const double cr = __builtin_fma(cp, r2, 1.0);
    const int q = ((int)n) & 3;
    s = (q == 0) ? sr : (q == 1) ? cr : (q == 2) ? -sr : -cr;
    c = (q == 0) ? cr : (q == 1) ? -sr : (q == 2) ? -cr : sr;
}

__device__ __forceinline__ void p0_prologue(Frame& F, const Args& args) {
    unsigned char* ws = args.ws;
    LAS float* scr = (LAS float*)(F.lds + RING_OFF + F.wave * 16384);
    const int gw = F.vcu * NWAVES + F.wave, NGW = F.G * NWAVES;
    constexpr int I0 = 16 * 96, I1 = 16 * 32, I7 = 16 * 176, I9 = 44 * 32;
    constexpr int NITEMS = I0 + 5 * I1 + 2 * I7 + 2 * I9;
    for (int it = gw; it < NITEMS; it += NGW) {
        int r = it; const float* W; int ldw, K, nblk, mode = 0, off = 0; size_t dst;
        if (r < I0) { W = args.in[1]; ldw = AWIN_LD; K = D; nblk = 96; dst = WS_WQKV0; }
        else if ((r -= I0) < I1) { W = args.in[3]; ldw = D; K = D; nblk = 32; dst = WS_WO0; }
        else if ((r -= I1) < I1) { W = args.in[5]; ldw = D; K = D; nblk = 32; dst = WS_WQKV1; mode = 1; }
        else if ((r -= I1) < I1) { W = args.in[4]; ldw = 2 * D; K = D; nblk = 32; dst = WS_WQKV1; mode = 1; off = D; }
        else if ((r -= I1) < I1) { W = args.in[4] + D; ldw = 2 * D; K = D; nblk = 32; dst = WS_WQKV1; off = 2 * D; }
        else if ((r -= I1) < I1) { W = args.in[8]; ldw = D; K = D; nblk = 32; dst = WS_WO1; }
        else if ((r -= I1) < I7) { W = args.in[9]; ldw = FF2; K = D; nblk = 176; dst = WS_WIN0; mode = 2; }
        else if ((r -= I7) < I7) { W = args.in[9] + (size_t)D * FF2; ldw = FF2; K = D; nblk = 176; dst = WS_WIN1; mode = 2; }
        else if ((r -= I7) < I9) { W = args.in[12]; ldw = D; K = FF; nblk = 32; dst = WS_WOUT0; }
        else { r -= I9; W = args.in[12] + (size_t)FF * D; ldw = D; K = FF; nblk = 32; dst = WS_WOUT1; }
        p0_transpose_item(W, ldw, K, nblk, (bf16*)(ws + dst), mode, off, scr, r, F.lane);
    }
    {
        float* cosT = (float*)(ws + WS_COS); float* sinT = (float*)(ws + WS_SIN);
        for (int e = (int)blockIdx.x * (NWAVES * 64) + F.tid; e < SEQ * 32; e += F.G * NWAVES * 64) {
            const int pos = e >> 5, i = e & 31;
            double invd = 1.0; for (int q_ = 0; q_ < i; ++q_) invd *= 0.7498942093324559;
            const float inv = (float)invd;
            const float ang = (float)pos * inv;
            double s, c; sincos_d((double)ang, s, c);
            cosT[e] = (float)c; sinT[e] = (float)s;
        }
    }
    __syncthreads();
    {
        LAS float* wf = (LAS float*)(F.lds + RING_OFF);
        const float* Win = args.in[1];
        for (int e = F.tid; e < 16 * D; e += NWAVES * 64) { const int k = e >> 4, h = e & 15; wf[h * D + k] = Win[(size_t)k * AWIN_LD + 3 * D + h]; }
        __syncthreads();
        const float* x = args.in[0]; bf16* XB = (bf16*)(ws + WS_XB); float* flog = (float*)(ws + WS_FLOG); const float* bfv = args.in[2];
        for (int m = gw; m < M; m += NGW) {
            const GAS f32x4* xr = (const GAS f32x4*)(x + (size_t)m * D) + F.lane;
            f32x4 v[4];
#pragma unroll
            for (int j = 0; j < 4; ++j) v[j] = xr[64 * j];
            GAS unsigned long long* o8 = (GAS unsigned long long*)(XB + (size_t)m * D) + F.lane;
#pragma unroll
            for (int j = 0; j < 4; ++j) o8[64 * j] = (unsigned long long)pk2(v[j].x, v[j].y) | ((unsigned long long)pk2(v[j].z, v[j].w) << 32);
            float mine = 0.f;
#pragma unroll 2
            for (int h = 0; h < 16; ++h) {
                float a = 0.f;
#pragma unroll
                for (int j = 0; j < 4; ++j) { const f32x4 w = *(const LAS f32x4*)(wf + h * D + 256 * j + 4 * F.lane); a += (v[j].x * w.x + v[j].y * w.y) + (v[j].z * w.z + v[j].w * w.w); }
                a = wave_sum(a);
                if (F.lane == h) mine = a;
            }
            if (F.lane < 16) flog[(size_t)m * 16 + F.lane] = mine + bfv[F.lane];
        }
    }
    __syncthreads();
}

__device__ __forceinline__ void scan_phase(Frame& F, const Args& args) {
    if (blockIdx.x >= BATCH * NH) return;
    const int bh = blockIdx.x, b = bh >> 4, h = bh & 15;
    const float* flog = (const float*)(args.ws + WS_FLOG); double* ck = (double*)(args.ws + WS_CK) + (size_t)bh * SEQ;
    LAS double* wtot = (LAS double*)(F.lds + RING_OFF);
    double loc[8]; double run = 0.0;
#pragma unroll
    for (int e = 0; e < 8; ++e) {
        const float f = flog[(size_t)(b * SEQ + F.tid * 8 + e) * 16 + h];
        const float ls = fminf(f, 0.f) - log1pf(expf(-fabsf(f)));
        run += (double)ls * 1.4426950408889634; loc[e] = run;
    }
    double inc = run;
#pragma unroll
    for (int o = 1; o < 64; o <<= 1) { const double t = __shfl_up(inc, o); if (F.lane >= o) inc += t; }
    if (F.lane == 63) wtot[F.wave] = inc;
    __syncthreads();
    double base = inc - run;
    for (int w = 0; w < F.wave; ++w) base += wtot[w];
    v4u* bt = (v4u*)(args.ws + WS_BT) + ((size_t)bh * SEQ + F.tid * 8) * 2;
#pragma unroll
    for (int e = 0; e < 8; ++e) {
        const double v = -(base + loc[e]);
        ck[F.tid * 8 + e] = base + loc[e];
        const unsigned hi = f2bf((float)v); const double r1 = v - (double)__uint_as_float(hi << 16);
        const unsigned mid = f2bf((float)r1); const double r2 = r1 - (double)__uint_as_float(mid << 16);
        const unsigned lo = f2bf((float)r2);
        bt[2 * e] = (v4u){hi | (mid << 16), lo | 0x3F800000u, 0x3F803F80u, 0u}; bt[2 * e + 1] = (v4u){0u, 0u, 0u, 0u};
    }
    __syncthreads();
}

__device__ __forceinline__ void ln_phase(Frame& F, const float* xin, const float* hs, const float* g, const float* bta, float* xout, bf16* xb, int row0, int nrows) {
    const int gw = F.vcu * NWAVES + F.wave, NGW = F.G * NWAVES;
    for (int r = gw; r < nrows; r += NGW) {
        const int m = row0 + r;
        const GAS f32x4* xr = (const GAS f32x4*)(xin + (size_t)m * D) + F.lane;
        const GAS f32x4* hr = (const GAS f32x4*)(hs + (size_t)r * D) + F.lane;
        f32x4 v[4]; float s = 0.f;
#pragma unroll
        for (int j = 0; j < 4; ++j) { v[j] = xr[64 * j] * DN_ALPHA + hr[64 * j]; s += (v[j].x + v[j].y) + (v[j].z + v[j].w); }
        const float mean = wave_sum(s) * (1.f / D); float s2 = 0.f;
#pragma unroll
        for (int j = 0; j < 4; ++j) { v[j] = v[j] - mean; s2 += (v[j].x * v[j].x + v[j].y * v[j].y) + (v[j].z * v[j].z + v[j].w * v[j].w); }
        const float rstd = 1.f / sqrtf(wave_sum(s2) * (1.f / D) + LN_EPS);
        GAS f32x4* xo = (GAS f32x4*)(xout + (size_t)m * D) + F.lane;
        GAS unsigned long long* o8 = (GAS unsigned long long*)(xb + (size_t)m * D) + F.lane;
#pragma unroll
        for (int j = 0; j < 4; ++j) {
            const f32x4 gg = *((const GAS f32x4*)g + F.lane + 64 * j), bb = *((const GAS f32x4*)bta + F.lane + 64 * j);
            const f32x4 y = v[j] * rstd * gg + bb;
            xo[64 * j] = y;
            o8[64 * j] = (unsigned long long)pk2(y.x, y.y) | ((unsigned long long)pk2(y.z, y.w) << 32);
        }
    }
}

__device__ __forceinline__ void conv_gate_phase(Frame& F, const bf16* U, const float* cw, const float* cb, bf16* Hh, int row0, int nrows) {
    const int NCH = FF / 8;
    const long total = (long)nrows * NCH;
    for (long it = (long)blockIdx.x * (NWAVES * 64) + F.tid; it < total; it += (long)F.G * NWAVES * 64) {
        const int lr = (int)(it / NCH), c8 = (int)(it % NCH), c = c8 * 8;
        const int s = (row0 + lr) % SEQ;
        const int ug = 256 * (c >> 7) + (c & 127), uv = ug + 128;
        float g[8], vv[8];
#pragma unroll
        for (int e = 0; e < 8; ++e) { g[e] = cb[c + e]; vv[e] = cb[FF + c + e]; }
#pragma unroll
        for (int j = 0; j < 3; ++j) {
            const int back = 2 - j;
            if (s >= back) {
                const bf16x8 a = *(const GAS bf16x8*)(U + (size_t)(lr - back) * FF2 + ug);
                const bf16x8 bq = *(const GAS bf16x8*)(U + (size_t)(lr - back) * FF2 + uv);
#pragma unroll
                for (int e = 0; e < 8; ++e) { g[e] += cw[j * FF2 + c + e] * bf2f((unsigned short)a[e]); vv[e] += cw[j * FF2 + FF + c + e] * bf2f((unsigned short)bq[e]); }
            }
        }
        v4u o; float r[8];
#pragma unroll
        for (int e = 0; e < 8; ++e) r[e] = g[e] / (1.f + expf(-g[e])) * vv[e];
        o.x = pk2(r[0], r[1]); o.y = pk2(r[2], r[3]); o.z = pk2(r[4], r[5]); o.w = pk2(r[6], r[7]);
        *(GAS v4u*)(Hh + (size_t)lr * FF + c) = o;
    }
}

__device__ __forceinline__ void rope_phase(Frame& F, bf16* Q1, bf16* K12, const float* cosT, const float* sinT) {
    const long total = (long)M * 256;
    for (long it = (long)blockIdx.x * (NWAVES * 64) + F.tid; it < total; it += (long)F.G * NWAVES * 64) {
        const int t = (int)(it >> 8), w = (int)(it & 255), ch = w & 127; bf16* buf = (w >> 7) ? K12 : Q1;
        const int a = ch & 7, s = t % SEQ;
        bf16* p = buf + (size_t)t * D + ch * 8;
        const bf16x8 v = *(const GAS bf16x8*)p;
        const f32x4 cs = *(const GAS f32x4*)(cosT + s * 32 + 4 * a), sn = *(const GAS f32x4*)(sinT + s * 32 + 4 * a);
        float o[8];
#pragma unroll
        for (int e = 0; e < 4; ++e) { const float t1 = bf2f((unsigned short)v[e]), t2 = bf2f((unsigned short)v[4 + e]); o[e] = t1 * cs[e] - t2 * sn[e]; o[4 + e] = t2 * cs[e] + t1 * sn[e]; }
        v4u ov; ov.x = pk2(o[0], o[1]); ov.y = pk2(o[2], o[3]); ov.z = pk2(o[4], o[5]); ov.w = pk2(o[6], o[7]);
        *(GAS v4u*)p = ov;
    }
}

__device__ __forceinline__ void attn_fox_simple(Frame& F, const bf16* Q, const bf16* K, const bf16* V, bf16* O, const double* ck) {
    LAS float* Ks = (LAS float*)(F.lds + RING_OFF);
    LAS float* Vs = (LAS float*)(F.lds + RING_OFF + 16384);
    LAS double* cks = (LAS double*)(F.lds + RING_OFF + 32768);
    const int bh = (int)blockIdx.x >> 2, jj = (int)blockIdx.x & 3, b = bh >> 4, h = bh & 15;
    for (int ui = 0; ui < 2; ++ui) {
        const int rb = ui == 0 ? jj : 7 - jj, q0 = rb * 512, row = q0 + F.tid;
        const size_t t = (size_t)b * SEQ + row;
        float q[64];
#pragma unroll
        for (int c = 0; c < 8; ++c) { const bf16x8 v = *(const GAS bf16x8*)(Q + t * D + h * 64 + c * 8);
#pragma unroll
            for (int e = 0; e < 8; ++e) q[c * 8 + e] = bf2f((unsigned short)v[e]); }
        const double cq = ck[(size_t)bh * SEQ + row];
        float o[64];
#pragma unroll
        for (int d = 0; d < 64; ++d) o[d] = 0.f;
        float mrun = -INFINITY, l = 0.f;
        const int nkt = (q0 + 512) / 64;
        for (int kt = 0; kt < nkt; ++kt) {
            __syncthreads();
            { const int r = F.tid >> 3, c = F.tid & 7; const size_t kr = ((size_t)b * SEQ + kt * 64 + r) * D + h * 64 + c * 8;
              const bf16x8 kv = *(const GAS bf16x8*)(K + kr); const bf16x8 vv = *(const GAS bf16x8*)(V + kr);
#pragma unroll
              for (int e = 0; e < 8; ++e) { Ks[r * 64 + c * 8 + e] = bf2f((unsigned short)kv[e]); Vs[r * 64 + c * 8 + e] = bf2f((unsigned short)vv[e]); }
              if (F.tid < 64) cks[F.tid] = ck[(size_t)bh * SEQ + kt * 64 + F.tid]; }
            __syncthreads();
            if (kt * 64 <= row) {
                for (int j = 0; j < 64; ++j) {
                    float s = 0.f;
#pragma unroll
                    for (int d = 0; d < 64; d += 4) { const f32x4 kk = *(const LAS f32x4*)(Ks + j * 64 + d); s += (q[d] * kk.x + q[d + 1] * kk.y) + (q[d + 2] * kk.z + q[d + 3] * kk.w); }
                    s += (float)(cq - cks[j]);
                    if (kt * 64 + j > row) s = -INFINITY;
                    if (s > mrun) { const float sc = exp2f(mrun - s); l *= sc;
#pragma unroll
                        for (int d = 0; d < 64; ++d) o[d] *= sc;
                        mrun = s; }
                    const float p = exp2f(s - mrun); l += p;
#pragma unroll
                    for (int d = 0; d < 64; d += 4) { const f32x4 vv = *(const LAS f32x4*)(Vs + j * 64 + d); o[d] += p * vv.x; o[d + 1] += p * vv.y; o[d + 2] += p * vv.z; o[d + 3] += p * vv.w; }
                }
            }
        }
        const float inv = 1.f / l;
#pragma unroll
        for (int c = 0; c < 8; ++c) { v4u w; w.x = pk2(o[c * 8] * inv, o[c * 8 + 1] * inv); w.y = pk2(o[c * 8 + 2] * inv, o[c * 8 + 3] * inv); w.z = pk2(o[c * 8 + 4] * inv, o[c * 8 + 5] * inv); w.w = pk2(o[c * 8 + 6] * inv, o[c * 8 + 7] * inv);
            *(GAS v4u*)(O + t * D + h * 64 + c * 8) = w; }
    }
    __syncthreads();
}
__device__ __forceinline__ void attn_diff_simple(Frame& F, const bf16* Q1, const bf16* K12, const bf16* V, bf16* O, float* S1, const float* lamp, const float* subg) {
    LAS float* Ks = (LAS float*)(F.lds + RING_OFF);
    LAS float* Vs = (LAS float*)(F.lds + RING_OFF + 16384);
    float s01 = 0.f, s23 = 0.f;
    for (int e = 0; e < 64; ++e) { s01 += lamp[e] * lamp[64 + e]; s23 += lamp[128 + e] * lamp[192 + e]; }
    const float lam = expf(s01) - expf(s23) + LAMBDA_INIT;
    const int bh = (int)blockIdx.x >> 3, jj = (int)blockIdx.x & 7, b = bh >> 3, h = bh & 7;
    const int half = F.tid & 1;
    for (int ui = 0; ui < 2; ++ui) {
        const int rb = ui == 0 ? jj : 15 - jj, q0 = rb * 256, row = q0 + (F.tid >> 1);
        const size_t t = (size_t)b * SEQ + row;
        const int nkt = (q0 + 256) / 64;
        for (int i = 0; i < 2; ++i) {
            float q[64];
#pragma unroll
            for (int c = 0; c < 8; ++c) { const bf16x8 v = *(const GAS bf16x8*)(Q1 + t * D + i * 512 + h * 64 + c * 8);
#pragma unroll
                for (int e = 0; e < 8; ++e) q[c * 8 + e] = bf2f((unsigned short)v[e]); }
            float o[64];
#pragma unroll
            for (int d = 0; d < 64; ++d) o[d] = 0.f;
            float mrun = -INFINITY, l = 0.f;
            for (int kt = 0; kt < nkt; ++kt) {
                __syncthreads();
                { const int r = F.tid >> 3, c = F.tid & 7; const size_t rowk = (size_t)b * SEQ + kt * 64 + r;
                  const bf16x8 kv = *(const GAS bf16x8*)(K12 + rowk * D + i * 512 + h * 64 + c * 8);
                  const bf16x8 v0 = *(const GAS bf16x8*)(V + rowk * D + h * 128 + c * 16); const bf16x8 v1 = *(const GAS bf16x8*)(V + rowk * D + h * 128 + c * 16 + 8);
#pragma unroll
                  for (int e = 0; e < 8; ++e) { Ks[r * 64 + c * 8 + e] = bf2f((unsigned short)kv[e]); Vs[r * 128 + c * 16 + e] = bf2f((unsigned short)v0[e]); Vs[r * 128 + c * 16 + 8 + e] = bf2f((unsigned short)v1[e]); } }
                __syncthreads();
                if (kt <= (row >> 6)) {
                    for (int j = 0; j < 64; ++j) {
                        float s = 0.f;
#pragma unroll
                        for (int d = 0; d < 64; d += 4) { const f32x4 kk = *(const LAS f32x4*)(Ks + j * 64 + d); s += (q[d] * kk.x + q[d + 1] * kk.y) + (q[d + 2] * kk.z + q[d + 3] * kk.w); }
                        if (s > mrun) { const float sc = exp2f(mrun - s); l *= sc;
#pragma unroll
                            for (int d = 0; d < 64; ++d) o[d] *= sc;
                            mrun = s; }
                        const float p = exp2f(s - mrun); l += p;
#pragma unroll
                        for (int d = 0; d < 64; d += 4) { const f32x4 vv = *(const LAS f32x4*)(Vs + j * 128 + half * 64 + d); o[d] += p * vv.x; o[d + 1] += p * vv.y; o[d + 2] += p * vv.z; o[d + 3] += p * vv.w; }
                    }
                }
            }
            const float inv = 1.f / l;
            float* sp = S1 + t * D + h * 128 + half * 64;
            if (i == 0) {
#pragma unroll
                for (int d = 0; d < 64; d += 4) *(GAS f32x4*)(sp + d) = (f32x4){o[d] * inv, o[d + 1] * inv, o[d + 2] * inv, o[d + 3] * inv};
            } else {
                float ss = 0.f;
#pragma unroll
                for (int d = 0; d < 64; d += 4) { const f32x4 a = *(const GAS f32x4*)(sp + d);
                    o[d] = a.x - lam * (o[d] * inv); o[d + 1] = a.y - lam * (o[d + 1] * inv); o[d + 2] = a.z - lam * (o[d + 2] * inv); o[d + 3] = a.w - lam * (o[d + 3] * inv);
                    ss += (o[d] * o[d] + o[d + 1] * o[d + 1]) + (o[d + 2] * o[d + 2] + o[d + 3] * o[d + 3]); }
                ss += __shfl_xor(ss, 1);
                const float rr = 1.f / sqrtf(ss * (1.f / 128.f) + RMS_EPS) * (1.f - LAMBDA_INIT);
#pragma unroll
                for (int c = 0; c < 8; ++c) { float y[8];
#pragma unroll
                    for (int e = 0; e < 8; ++e) y[e] = o[c * 8 + e] * rr * subg[half * 64 + c * 8 + e];
                    v4u w; w.x = pk2(y[0], y[1]); w.y = pk2(y[2], y[3]); w.z = pk2(y[4], y[5]); w.w = pk2(y[6], y[7]);
                    *(GAS v4u*)(O + t * D + h * 128 + half * 64 + c * 8) = w; }
            }
        }
    }
    __syncthreads();
}

enum Phase { PH_PRO = 0, PH_QKV0, PH_ATT0, PH_WO0, PH_LNA0,
             PH_UP0A, PH_CV0A, PH_DN0A, PH_LNF0A, PH_UP0B, PH_CV0B, PH_DN0B, PH_LNF0B,
             PH_QKV1, PH_ROPE1, PH_ATT1, PH_WO1, PH_LNA1,
             PH_UP1A, PH_CV1A, PH_DN1A, PH_LNF1A, PH_UP1B, PH_CV1B, PH_DN1B, PH_LNF1B, PH_COUNT };

#define EN(b) ((PHMASK >> (b)) & 1u)
template <unsigned PHMASK> __global__ void __launch_bounds__(NWAVES * 64, 2) yoco_fwd(Args args) {
    extern __shared__ __attribute__((aligned(16))) unsigned char lds[];
    Frame F;
    F.lds = (LAS unsigned char*)lds;
    F.MISC = (volatile LAS unsigned*)(F.lds + MISC_OFF);
    F.tid = threadIdx.x; F.lane = F.tid & 63; F.wave = __builtin_amdgcn_readfirstlane(F.tid >> 6);
    F.G = gridDim.x; { const int bx = blockIdx.x; F.vcu = (F.G % 8 == 0) ? (bx % 8) * (F.G / 8) + bx / 8 : bx; }
    unsigned char* ws = args.ws;
    F.ctl = (gu32*)(ws + WS_CTL);
    for (int u = F.tid; u < (LDS_BYTES - LDSCTL_OFF) / 4; u += NWAVES * 64) ((LAS unsigned*)(F.lds + LDSCTL_OFF))[u] = 0u;
    __syncthreads();
    XcdBarrier bar; bar.bar = (unsigned*)(F.ctl + CW_BAR); bar.x = 0; bar.st = nullptr;
    const bool multi = (args.ph_hi - args.ph_lo) > 1;
    if (multi) bar = xcd_barrier_post((unsigned*)(F.ctl + CW_BAR), F.MISC + 8);

    if (EN(2) && args.ph_lo == PH_PRO) p0_prologue(F, args);
    for (int ph = args.ph_lo; ph < args.ph_hi; ++ph) {
        { int t_ = threadIdx.x; asm volatile("" : "+v"(t_)); F.tid = t_; F.lane = t_ & 63; F.wave = __builtin_amdgcn_readfirstlane(t_ >> 6); }
        bf16* XB = (bf16*)(ws + WS_XB); bf16* QO = (bf16*)(ws + WS_QO); bf16* KB = (bf16*)(ws + WS_KB); bf16* VB = (bf16*)(ws + WS_VB);
        float* HS = (float*)(ws + WS_HS); bf16* UH = (bf16*)(ws + WS_UH); bf16* HH = (bf16*)(ws + WS_HH); float* HSH = (float*)(ws + WS_HSH);
        const float* cosT = (const float*)(ws + WS_COS); const float* sinT = (const float*)(ws + WS_SIN);

        int kind = 0; pg8::Gemm g{nullptr, nullptr, 0, 0, 0};
        bf16* ob = nullptr; int ob_ld = 0, ob_split = 0; size_t ob_stride = 0; float ob_scale = 1.f; float* of = nullptr;
        const int layer = ph >= PH_QKV1 ? 1 : 0;
        const bf16* WIN = (const bf16*)(ws + (layer ? WS_WIN1 : WS_WIN0)); const bf16* WOUT = (const bf16*)(ws + (layer ? WS_WOUT1 : WS_WOUT0));
        int half = 0;
        switch (ph) {
            case PH_QKV0: kind = 1; g = pg8::Gemm{XB, (const bf16*)(ws + WS_WQKV0), M, 3 * D, D}; ob = QO; ob_ld = D; ob_split = D; ob_stride = (WS_KB - WS_QO) / 2; ob_scale = C2; break;
            case PH_QKV1: kind = 1; g = pg8::Gemm{XB, (const bf16*)(ws + WS_WQKV1), M, 3 * D, D}; ob = QO; ob_ld = D; ob_split = D; ob_stride = (WS_KB - WS_QO) / 2; ob_scale = C2; break;
            case PH_WO0: kind = 2; g = pg8::Gemm{QO, (const bf16*)(ws + WS_WO0), M, D, D}; of = HS; break;
            case PH_WO1: kind = 2; g = pg8::Gemm{XB, (const bf16*)(ws + WS_WO1), M, D, D}; of = HS; break;
            case PH_UP0B: case PH_UP1B: half = 1; [[fallthrough]];
            case PH_UP0A: case PH_UP1A: kind = 1; g = pg8::Gemm{XB + (size_t)half * (M / 2) * D, WIN, M / 2, FF2, D}; ob = UH; ob_ld = FF2; break;
            case PH_DN0B: case PH_DN1B: half = 1; [[fallthrough]];
            case PH_DN0A: case PH_DN1A: kind = 2; g = pg8::Gemm{HH, WOUT, M / 2, D, FF}; of = HSH; break;
            case PH_CV0B: case PH_CV1B: case PH_LNF0B: case PH_LNF1B: half = 1; break;
            default: break;
        }
        if (EN(0) && kind == 1) {
            pg8::StaticOrder S; S.init(g.M, g.N, F.G, (int)blockIdx.x);
            pg8::EpiBf16<0> E{ob, ob_ld, nullptr, ob_split, ob_stride, ob_scale};
            if (ph == PH_QKV0) scan_phase(F, args);
            pg8::gemm_phase<pg8::EpiBf16<0>, pg8::StaticOrder, PG8_ALIGN, PG8_SP2>(F.lds + RING_OFF, g, S, E);
        } else if (EN(1) && kind == 2) {
            pg8::StaticOrder S; S.init(g.M, g.N, F.G, (int)blockIdx.x);
            pg8::EpiF32 E{of, D};
            pg8::gemm_phase<pg8::EpiF32, pg8::StaticOrder, PG8_ALIGN, PG8_SP2>(F.lds + RING_OFF, g, S, E);
        } else if (EN(3) && ph == PH_ATT0) {
            const attn_body::AttnTensors AT{(const attn_body::bf16*)QO, (const attn_body::bf16*)KB, (const attn_body::bf16*)VB, (attn_body::bf16*)QO};
            const attn_body::StaticOrder S((int)F.G, (int)blockIdx.x);
            attn_body::attn_phase<attn_body::StaticOrder, 8, true>((char*)lds + RING_OFF, AT, S, ws + WS_BT);
        } else if (EN(4) && ph == PH_ATT1) {
            attn_diff_simple(F, QO, KB, VB, XB, HS, args.in[6], args.in[7]);
        } else if (EN(5) && ph == PH_ROPE1) {
            rope_phase(F, QO, KB, cosT, sinT);
        } else if (EN(6) && ph == PH_LNA0) {
            ln_phase(F, args.in[0], HS, args.in[13], args.in[14], args.out, XB, 0, M);
        } else if (EN(6) && ph == PH_LNA1) {
            ln_phase(F, args.out, HS, args.in[13] + D, args.in[14] + D, args.out, XB, 0, M);
        } else if (EN(7) && (ph == PH_CV0A || ph == PH_CV0B || ph == PH_CV1A || ph == PH_CV1B)) {
            conv_gate_phase(F, UH, args.in[10] + (size_t)layer * 3 * FF2, args.in[11] + (size_t)layer * FF2, HH, half * (M / 2), M / 2);
        } else if (EN(6) && (ph == PH_LNF0A || ph == PH_LNF0B || ph == PH_LNF1A || ph == PH_LNF1B)) {
            ln_phase(F, args.out, HSH, args.in[15] + (size_t)layer * D, args.in[16] + (size_t)layer * D, args.out, XB, half * (M / 2), M / 2);
        }
        if (ph + 1 < args.ph_hi) xcd_barrier(bar);
    }
}

#ifndef ONE_LAUNCH
#define ONE_LAUNCH 1
#endif
static unsigned phase_mask(int ph) {
    switch (ph) {
        case PH_QKV0: case PH_QKV1: case PH_UP0A: case PH_UP0B: case PH_UP1A: case PH_UP1B: return 0x1u;
        case PH_WO0: case PH_WO1: case PH_DN0A: case PH_DN0B: case PH_DN1A: case PH_DN1B: return 0x2u;
        case PH_PRO: return 0x4u;
        case PH_ATT0: return 0x8u;
        case PH_ATT1: return 0x10u;
        default: return 0xE0u;
    }
}
template <unsigned MASK> static void launch_one(int grid, const Args& a, hipStream_t stream) {
    static bool attr_done = false;
    if (!attr_done) { (void)hipFuncSetAttribute((const void*)yoco_fwd<MASK>, hipFuncAttributeMaxDynamicSharedMemorySize, LDS_BYTES); attr_done = true; }
    hipLaunchKernelGGL(yoco_fwd<MASK>, dim3(grid), dim3(NWAVES * 64), LDS_BYTES, stream, a);
}
extern "C" void kernel_launch(void* const* d_in, const int* in_sizes, int n_in, void* d_out, int out_size, void* d_ws, size_t ws_size, hipStream_t stream) {
    static int grid = 0;
    if (grid == 0) {
        if (n_in != 17 || out_size != M * D || ws_size < WS_END) { fprintf(stderr, "kernel_launch: unexpected shapes (n_in %d out %d ws %zu)\n", n_in, out_size, ws_size); grid = -1; return; }
        int dev = 0, cus = 0;
        if (hipGetDevice(&dev) != hipSuccess || hipDeviceGetAttribute(&cus, hipDeviceAttributeMultiprocessorCount, dev) != hipSuccess) { grid = -1; return; }
        (void)hipGetLastError();
        grid = cus;
        if (grid != 256) fprintf(stderr, "kernel_launch: %d CUs; this build expects 256\n", grid);
    }
    if (grid < 0) return;
    (void)hipMemsetAsync((char*)d_ws + WS_CTL, 0, CTL_ZERO_BYTES, stream);
    Args a{};
    for (int i = 0; i < 17; ++i) a.in[i] = (const float*)d_in[i];
    a.out = (float*)d_out; a.ws = (unsigned char*)d_ws;
#if ONE_LAUNCH
    a.ph_lo = 0; a.ph_hi = PH_COUNT; launch_one<0xFFu>(grid, a, stream);
#else
    for (int ph = 0; ph < PH_COUNT; ++ph) {
        a.ph_lo = ph; a.ph_hi = ph + 1;
        switch (phase_mask(ph)) {
            case 0x1u: launch_one<0x1u>(grid, a, stream); break;
            case 0x2u: launch_one<0x2u>(grid, a, stream); break;
            case 0x4u: launch_one<0x4u>(grid, a, stream); break;
            case 0x8u: launch_one<0x8u>(grid, a, stream); break;
            case 0x10u: launch_one<0x10u>(grid, a, stream); break;
            default: launch_one<0xE0u>(grid, a, stream); break;
        }
    }
#endif
}
```

```cpp
#include <hip/hip_runtime.h>
#include <hip/hip_bf16.h>
#include <cstdio>
#include <cstdint>
#include <cmath>
namespace pg8 {
#define PG8_LAS __attribute__((address_space(3)))
typedef unsigned short bf16_t;
typedef short bf16x8 __attribute__((ext_vector_type(8)));
typedef float f32x4 __attribute__((ext_vector_type(4)));
typedef unsigned u32x4 __attribute__((ext_vector_type(4)));
constexpr int BM = 256, BK = 64, HALF = 128, HTB = HALF * BK * 2  , STAGE_BYTES = 8 * HTB, NXCD = 8, WGM = 8;

__host__ __device__ __forceinline__ int lds_byte(int r, int c) { const int st = (r >> 4) * 2 + (c >> 5), rr = r & 15, cc = c & 31, ob = rr * 64 + cc * 2; return st * 1024 + (ob ^ (((ob >> 9) & 1) << 5)); }
__host__ __device__ __forceinline__ void stage_rc(int b, int& R, int& C) { const int st = b / 1024, sb = b % 1024, swz = sb ^ (((sb >> 9) & 1) << 5); R = (st >> 1) * 16 + swz / 64; C = (st & 1) * 32 + (swz % 64) / 2; }
__host__ __device__ __forceinline__ int perm32(int rho) { const int n = rho >> 4, i = rho & 15; return 8 * (i >> 2) + 4 * n + (i & 3); }

struct Unit { int pm, pn; };
struct Gemm { const bf16_t* A; const bf16_t* Bt; int M, N, K; };

struct StaticOrder {
    int nM, nN, nwg, G, c;
    __host__ __device__ void init(int M, int N, int G_, int c_) { nM = M / BM; nN = N / BM; nwg = nM * nN; G = G_; c = c_; }
    __host__ __device__ bool next(int i, Unit& u) const {
        const long L = (long)i * G + c; if (L >= nwg) return false;
        int wgid = (int)L; { const int q = nwg / NXCD, r = nwg % NXCD, xcd = wgid % NXCD, off = wgid / NXCD; wgid = (xcd < r ? xcd * (q + 1) : r * (q + 1) + (xcd - r) * q) + off; }
        const int nig = WGM * nN, gid = wgid / nig, fm = gid * WGM, gsz = (nM - fm) < WGM ? (nM - fm) : WGM;
        u.pm = fm + ((wgid % nig) % gsz); u.pn = (wgid % nig) / gsz; return true;
    }
    __device__ __forceinline__ void a_ready(const Unit&) const {}
    __device__ __forceinline__ void done(const Unit&) const {}
};

__device__ __forceinline__ unsigned cvt_pk_bf16(float lo, float hi) { unsigned r; asm volatile("v_cvt_pk_bf16_f32 %0, %1, %2" : "=v"(r) : "v"(lo), "v"(hi)); return r; }
typedef float f32x2 __attribute__((ext_vector_type(2)));
__device__ __forceinline__ f32x2 gelu_pk(f32x2 v) {
    const f32x2 av = __builtin_elementwise_abs(v), d = av * 0.2316418882f + 1.0f;
    f32x2 t; t.x = __builtin_amdgcn_rcpf(d.x); t.y = __builtin_amdgcn_rcpf(d.y);
    f32x2 q = t * 0.5307027145f + (-0.7265760135f); q = q * t + 0.7107068705f; q = q * t + (-0.142248368f); q = q * t + 0.127414796f; q = q * t;
    const f32x2 s = (v * v) * (-0.72134752044f);
    f32x2 e; e.x = __builtin_amdgcn_exp2f(s.x); e.y = __builtin_amdgcn_exp2f(s.y);
    const f32x2 m = v * (q * e), r = v - m;
    f32x2 o; o.x = v.x < 0.f ? m.x : r.x; o.y = v.y < 0.f ? m.y : r.y; return o;
}

template <int ACT  > struct EpiBf16 {
    static constexpr bool PERM = true, AFTER_DRAIN = false; static_assert(ACT == 0 || ACT == 1, "EpiBf16: ACT is 0 (none) or 1 (gelu_pk)");
    bf16_t* O; int ldc; const float* bias; int split_cols; size_t split_stride; float scale0;
    __device__ __forceinline__ void operator()(const f32x4 (&acc)[2][2][4][2], const Unit& u, int wr, int wc, int fr, int fq) const {
        const int row0 = u.pm * BM + wr * 64 + fr; int colt = u.pn * BM; bf16_t* base = O;
        float sc = 1.f; if (split_cols) { const int t = colt / split_cols; base += (size_t)t * split_stride; colt -= t * split_cols; if (t == 0) sc = scale0; }
        const int col0 = colt + wc * 32 + 8 * fq, bcol0 = u.pn * BM + wc * 32 + 8 * fq;
        f32x4 bv[2][2];
#pragma unroll
        for (int bj = 0; bj < 2; ++bj)
#pragma unroll
            for (int n = 0; n < 2; ++n) bv[bj][n] = bias ? *(const f32x4*)(bias + bcol0 + bj * HALF + 4 * n) : (f32x4){0.f, 0.f, 0.f, 0.f};
#pragma unroll
        for (int ai = 0; ai < 2; ++ai)
#pragma unroll
            for (int m = 0; m < 4; ++m) { bf16_t* rowp = base + (size_t)(row0 + ai * HALF + m * 16) * ldc + col0;
#pragma unroll
                for (int bj = 0; bj < 2; ++bj) { f32x4 v0 = acc[ai][bj][m][0] + bv[bj][0], v1 = acc[ai][bj][m][1] + bv[bj][1];
                    if (ACT == 1) { f32x2 a = gelu_pk((f32x2){v0[0], v0[1]}), b = gelu_pk((f32x2){v0[2], v0[3]}), c = gelu_pk((f32x2){v1[0], v1[1]}), d = gelu_pk((f32x2){v1[2], v1[3]});
                        v0 = (f32x4){a.x, a.y, b.x, b.y}; v1 = (f32x4){c.x, c.y, d.x, d.y}; }
                    v0 = v0 * sc; v1 = v1 * sc; u32x4 w; w.x = cvt_pk_bf16(v0[0], v0[1]); w.y = cvt_pk_bf16(v0[2], v0[3]); w.z = cvt_pk_bf16(v1[0], v1[1]); w.w = cvt_pk_bf16(v1[2], v1[3]);
                    *(u32x4*)(rowp + bj * HALF) = w; } }
    }
};

struct PanelStats {
    unsigned* xbuf;
    unsigned* cnt;
    unsigned* tmo;
    int ntn; float eps;
    unsigned code;
    __device__ __forceinline__ bool run(const f32x4 (&v)[2][2][4][2], const Unit& u, int wr, int wc, int fr, int fq, PG8_LAS unsigned char* lds, int wid, int lane) const {
        typedef float f32x2v __attribute__((ext_vector_type(2)));
        PG8_LAS f32x2v* P = (PG8_LAS f32x2v*)lds;
        PG8_LAS f32x2v* S = (PG8_LAS f32x2v*)(lds + 8192);
        PG8_LAS unsigned* flag = (PG8_LAS unsigned*)(lds + 8192 + 2048);
#pragma unroll
        for (int ai = 0; ai < 2; ++ai)
#pragma unroll
            for (int m = 0; m < 4; ++m) {
                float s = 0.f;
#pragma unroll
                for (int bj = 0; bj < 2; ++bj)
#pragma unroll
                    for (int n = 0; n < 2; ++n) { const f32x4 x = v[ai][bj][m][n]; s += (x[0] + x[1]) + (x[2] + x[3]); }
                s += __shfl_xor(s, 16); s += __shfl_xor(s, 32);
                const float mw = s * (1.0f / 64.0f); float q = 0.f;
#pragma unroll
                for (int bj = 0; bj < 2; ++bj)
#pragma unroll
                    for (int n = 0; n < 2; ++n) { const f32x4 d = v[ai][bj][m][n] - mw; q += (d[0] * d[0] + d[1] * d[1]) + (d[2] * d[2] + d[3] * d[3]); }
                q += __shfl_xor(q, 16); q += __shfl_xor(q, 32);
                if (fq == 0) P[(ai * HALF + wr * 64 + m * 16 + fr) * 4 + wc] = (f32x2v){mw, q};
            }
        asm volatile("s_waitcnt lgkmcnt(0)" ::: "memory"); __builtin_amdgcn_s_barrier(); asm volatile("" ::: "memory");
#if defined(BROKEN_EXCHANGE_NO_WAIT)
#warning BROKEN CONTROL BUILD: the row-statistics exchange does not wait; results are wrong by design
        if (blockIdx.x >= 64) { const long long t0_ = clock64(); while (clock64() - t0_ < 60000) __builtin_amdgcn_s_sleep(8); }
#endif
        const int row = wid * 32 + (lane & 31);
        if (lane < 32) {
            const f32x2v a = P[row * 4 + 0], b = P[row * 4 + 1], c = P[row * 4 + 2], d = P[row * 4 + 3];
            const float mt = (a.x + b.x + c.x + d.x) * 0.25f;
            const float da = a.x - mt, db = b.x - mt, dc = c.x - mt, dd = d.x - mt;
            const float m2 = (a.y + b.y) + (c.y + d.y) + 64.0f * ((da * da + db * db) + (dc * dc + dd * dd));
            unsigned long long* slot = (unsigned long long*)xbuf + ((size_t)(u.pm * BM + row) * 4 + u.pn);
            __hip_atomic_store(slot, ((unsigned long long)__float_as_uint(m2) << 32) | __float_as_uint(mt), __ATOMIC_RELAXED, __HIP_MEMORY_SCOPE_AGENT);
        }
        asm volatile("s_waitcnt vmcnt(0)" ::: "memory");
        if (lane == 0) __hip_atomic_fetch_add(cnt + 64 * u.pm, 1u, __ATOMIC_RELAXED, __HIP_MEMORY_SCOPE_AGENT);
        if (wid == 0) {
            bool dead = false; const unsigned long long t0 = __builtin_amdgcn_s_memrealtime(); const unsigned want = 8u * (unsigned)ntn;
            for (;;) {
#if defined(BROKEN_EXCHANGE_NO_WAIT)
                break;
#endif
                if ((unsigned)__builtin_amdgcn_readfirstlane(__hip_atomic_load(cnt + 64 * u.pm, __ATOMIC_RELAXED, __HIP_MEMORY_SCOPE_AGENT)) >= want) break;
                if (__builtin_amdgcn_s_memrealtime() - t0 > 2000000ull) {
                    if (lane == 0) { unsigned expect = 0u; __hip_atomic_compare_exchange_strong(tmo + 1, &expect, code | (unsigned)(u.pm & 0xff), __ATOMIC_RELAXED, __ATOMIC_RELAXED, __HIP_MEMORY_SCOPE_AGENT);
                                     __hip_atomic_store(tmo, 1u, __ATOMIC_RELAXED, __HIP_MEMORY_SCOPE_AGENT); }
                    dead = true; break; }
                __builtin_amdgcn_s_sleep(2);
            }
            __builtin_amdgcn_fence(__ATOMIC_ACQUIRE, "agent");
            if (lane == 0) flag[0] = dead ? 1u : 0u;
        }
        asm volatile("s_waitcnt vmcnt(0) lgkmcnt(0)" ::: "memory"); __builtin_amdgcn_s_barrier(); asm volatile("" ::: "memory");
        const bool bad = flag[0] != 0u;
        if (lane < 32) {
            const unsigned long long* slot = (const unsigned long long*)xbuf + (size_t)(u.pm * BM + row) * 4; float mt[4], m2[4]; float ms = 0.f;
#pragma unroll
            for (int t = 0; t < 4; ++t) { if (t < ntn) { const unsigned long long w = __hip_atomic_load(slot + t, __ATOMIC_RELAXED, __HIP_MEMORY_SCOPE_AGENT); mt[t] = __uint_as_float((unsigned)w); m2[t] = __uint_as_float((unsigned)(w >> 32)); } else { mt[t] = 0.f; m2[t] = 0.f; } ms += mt[t]; }
            const float mean = ms / (float)ntn; float q = 0.f;
#pragma unroll
            for (int t = 0; t < 4; ++t) if (t < ntn) { const float dm = mt[t] - mean; q += m2[t] + 256.0f * dm * dm; }
            S[row] = (f32x2v){mean, 1.0f / sqrtf(q / (256.0f * (float)ntn) + eps)};
        }
        asm volatile("s_waitcnt lgkmcnt(0)" ::: "memory"); __builtin_amdgcn_s_barrier(); asm volatile("" ::: "memory");
        return bad;
    }
};
struct EpiLnRes {
    static constexpr bool PERM = false, AFTER_DRAIN = true;
    const float* base; float* out; int ldc; const float* bias; PanelStats st; unsigned poison;
    __device__ __forceinline__ void fused(f32x4 (&acc)[2][2][4][2], const Unit& u, int wr, int wc, int fr, int fq, PG8_LAS unsigned char* lds, int wid, int lane) const {
        typedef float f32x2v __attribute__((ext_vector_type(2)));
        const PG8_LAS f32x2v* S = (const PG8_LAS f32x2v*)(lds + 8192);
        const int col0 = u.pn * BM + wc * 32 + 4 * fq;
#pragma unroll
        for (int bj = 0; bj < 2; ++bj)
#pragma unroll
            for (int n = 0; n < 2; ++n) { const f32x4 bv = bias ? *(const f32x4*)(bias + col0 + bj * HALF + n * 16) : (f32x4){0.f, 0.f, 0.f, 0.f};
#pragma unroll
                for (int ai = 0; ai < 2; ++ai)
#pragma unroll
                    for (int m = 0; m < 4; ++m) acc[ai][bj][m][n] += bv; }
        f32x4 pre[4][2][2];
#pragma unroll
        for (int m = 0; m < 4; ++m) { const size_t off = (size_t)(u.pm * BM + wr * 64 + m * 16 + fr) * ldc + col0;
#pragma unroll
            for (int bj = 0; bj < 2; ++bj)
#pragma unroll
                for (int n = 0; n < 2; ++n) pre[m][bj][n] = *(const f32x4*)(base + off + bj * HALF + n * 16); }
        const bool bad = st.run(acc, u, wr, wc, fr, fq, lds, wid, lane) || poison != 0u;
        const float qnan = __builtin_nanf("");
#pragma unroll
        for (int ai = 0; ai < 2; ++ai)
#pragma unroll
            for (int m = 0; m < 4; ++m) { const int r = ai * HALF + wr * 64 + m * 16 + fr; const f32x2v sr = S[r]; const size_t off = (size_t)(u.pm * BM + r) * ldc + col0;
#pragma unroll
                for (int bj = 0; bj < 2; ++bj)
#pragma unroll
                    for (int n = 0; n < 2; ++n) { const f32x4 bs = ai == 0 ? pre[m][bj][n] : *(const f32x4*)(base + off + bj * HALF + n * 16); f32x4 o = bs + (acc[ai][bj][m][n] - sr.x) * sr.y;
                        if (bad) o = (f32x4){qnan, qnan, qnan, qnan}; *(f32x4*)(out + off + bj * HALF + n * 16) = o; }
                if (m & 1) asm volatile("" ::: "memory"); }
    }
};
struct EpiLnResLn {
    static constexpr bool PERM = false, AFTER_DRAIN = true;
    const float* base; float* out; bf16_t* xn; int ldc; const float* bias; PanelStats st1, st2; unsigned poison;
    __device__ __forceinline__ void fused(f32x4 (&acc)[2][2][4][2], const Unit& u, int wr, int wc, int fr, int fq, PG8_LAS unsigned char* lds, int wid, int lane) const {
        typedef float f32x2v __attribute__((ext_vector_type(2))); typedef unsigned u32x2v __attribute__((ext_vector_type(2)));
        const PG8_LAS f32x2v* S = (const PG8_LAS f32x2v*)(lds + 8192);
        const int col0 = u.pn * BM + wc * 32 + 4 * fq;
#pragma unroll
        for (int bj = 0; bj < 2; ++bj)
#pragma unroll
            for (int n = 0; n < 2; ++n) { const f32x4 bv = bias ? *(const f32x4*)(bias + col0 + bj * HALF + n * 16) : (f32x4){0.f, 0.f, 0.f, 0.f};
#pragma unroll
                for (int ai = 0; ai < 2; ++ai)
#pragma unroll
                    for (int m = 0; m < 4; ++m) acc[ai][bj][m][n] += bv; }
        bool bad = st1.run(acc, u, wr, wc, fr, fq, lds, wid, lane) || poison != 0u;
        const float qnan = __builtin_nanf("");
#pragma unroll
        for (int ai = 0; ai < 2; ++ai)
#pragma unroll
            for (int m = 0; m < 4; ++m) { const int r = ai * HALF + wr * 64 + m * 16 + fr; const f32x2v sr = S[r]; const size_t off = (size_t)(u.pm * BM + r) * ldc + col0;
#pragma unroll
                for (int bj = 0; bj < 2; ++bj)
#pragma unroll
                    for (int n = 0; n < 2; ++n) { const f32x4 bs = *(const f32x4*)(base + off + bj * HALF + n * 16); acc[ai][bj][m][n] = bs + (acc[ai][bj][m][n] - sr.x) * sr.y; }
                asm volatile("" : "+v"(acc[ai][0][m][0]), "+v"(acc[ai][0][m][1]), "+v"(acc[ai][1][m][0]), "+v"(acc[ai][1][m][1]));
                if (m & 1) asm volatile("" ::: "memory"); }
        const bool bad1 = bad;
        bad = st2.run(acc, u, wr, wc, fr, fq, lds, wid, lane) || bad;
#pragma unroll
        for (int ai = 0; ai < 2; ++ai)
#pragma unroll
            for (int m = 0; m < 4; ++m) { const int r = ai * HALF + wr * 64 + m * 16 + fr; const f32x2v sr = S[r]; const size_t off = (size_t)(u.pm * BM + r) * ldc + col0;
#pragma unroll
                for (int bj = 0; bj < 2; ++bj)
#pragma unroll
                    for (int n = 0; n < 2; ++n) { const f32x4 x1 = acc[ai][bj][m][n]; *(f32x4*)(out + off + bj * HALF + n * 16) = bad1 ? (f32x4){qnan, qnan, qnan, qnan} : x1;
                        const f32x4 o = (x1 - sr.x) * sr.y; u32x2v w; w.x = cvt_pk_bf16(o[0], o[1]); w.y = cvt_pk_bf16(o[2], o[3]);
                        if (bad) { w.x = 0x7fc07fc0u; w.y = 0x7fc07fc0u; } *(u32x2v*)(xn + off + bj * HALF + n * 16) = w; }
                asm volatile("" ::: "memory"); }
    }
};

template <class Epi, class Sched, bool ALIGN_EPI = false, bool SP2 = false>
__device__ __forceinline__ void gemm_phase(PG8_LAS unsigned char* lds, const Gemm g, const Sched& S, const Epi& E) {
    int tid_ = threadIdx.x; asm volatile("" : "+v"(tid_));
    const int tid = tid_, wid = __builtin_amdgcn_readfirstlane(tid >> 6), lane = tid & 63, wr = wid >> 2, wc = wid & 3, fr = lane & 15, fq = lane >> 4;
    const int K = g.K, nt = K / BK;
    unsigned voffA[2], voffB[2];
#pragma unroll
    for (int i = 0; i < 2; ++i) { int R, C; stage_rc(tid * 16 + i * 8192, R, C); const int Rb = Epi::PERM ? ((R & ~31) + perm32(R & 31)) : R;
        voffA[i] = (unsigned)(R * K + C) * 2u; voffB[i] = (unsigned)(Rb * K + C) * 2u; }
    const size_t kstep = (size_t)(BK * 2);
    const size_t hstep = (size_t)HALF * K * 2;
    const size_t tstep = 2 * hstep;
    const unsigned ldsw = (unsigned)wid * 1024u;
    const int aoff = lds_byte(wr * 64 + fr, fq * 8), boff = lds_byte(wc * 32 + fr, fq * 8);
#define PG8_SA(b, h) (((b) * 2 + (h)) * HTB)
#define PG8_SB(b, h) ((4 + (b) * 2 + (h)) * HTB)
#define PG8_STAGE(bufoff, gbase, voff) do { _Pragma("unroll") for (int _i = 0; _i < 2; ++_i) \
        __builtin_amdgcn_global_load_lds((const unsigned*)((const char*)(gbase) + (voff)[_i]), (PG8_LAS unsigned*)(lds + (bufoff) + ldsw + _i * 8192), 16, 0, 0); } while (0)
#define PG8_LDA(dst, b, h) do { _Pragma("unroll") for (int m = 0; m < 4; ++m) _Pragma("unroll") for (int k = 0; k < 2; ++k) dst[m][k] = *(const PG8_LAS bf16x8*)(lds + PG8_SA(b, h) + aoff + m * 2048 + k * 1024); } while (0)
#define PG8_LDB(dst, b, h) do { _Pragma("unroll") for (int n = 0; n < 2; ++n) _Pragma("unroll") for (int k = 0; k < 2; ++k) dst[n][k] = *(const PG8_LAS bf16x8*)(lds + PG8_SB(b, h) + boff + n * 2048 + k * 1024); } while (0)
#define PG8_MMA(ai, bj, At, Bt) do { __builtin_amdgcn_s_setprio(1); _Pragma("unroll") for (int m = 0; m < 4; ++m) _Pragma("unroll") for (int n = 0; n < 2; ++n) _Pragma("unroll") for (int k = 0; k < 2; ++k) \
        acc[ai][bj][m][n] = __builtin_amdgcn_mfma_f32_16x16x32_bf16(Bt[n][k], At[m][k], acc[ai][bj][m][n], 0, 0, 0); __builtin_amdgcn_s_setprio(0); } while (0)
#define PG8_WAIT_V(n) asm volatile("s_waitcnt vmcnt(" #n ")" ::: "memory")
#define PG8_WAIT_L(n) asm volatile("s_waitcnt lgkmcnt(" #n ")" ::: "memory")
#define PG8_BAR __builtin_amdgcn_s_barrier()
#define PG8_SCHED __builtin_amdgcn_sched_barrier(0)
    Unit cur, nxt; int ui = 0;
    if (!S.next(0, cur)) return;
    f32x4 acc[2][2][4][2];
#pragma unroll
    for (int a = 0; a < 2; ++a)
#pragma unroll
        for (int b = 0; b < 2; ++b)
#pragma unroll
            for (int m = 0; m < 4; ++m)
#pragma unroll
                for (int n = 0; n < 2; ++n) acc[a][b][m][n] = (f32x4){0.f, 0.f, 0.f, 0.f};
    bf16x8 At[4][2], B0[2][2], B1[2][2];
    const char* cA = (const char*)g.A + (size_t)cur.pm * tstep; const char* cB = (const char*)g.Bt + (size_t)cur.pn * tstep;
    S.a_ready(cur);
    if constexpr (SP2) {
        PG8_STAGE(PG8_SB(0, 0), cB, voffB); PG8_STAGE(PG8_SB(0, 1), cB + hstep, voffB); PG8_STAGE(PG8_SA(0, 0), cA, voffA); PG8_STAGE(PG8_SA(0, 1), cA + hstep, voffA);
        if (wr == 1) PG8_BAR;
        PG8_WAIT_V(2); PG8_BAR;
        PG8_STAGE(PG8_SB(1, 0), cB + kstep, voffB); PG8_STAGE(PG8_SA(1, 0), cA + kstep, voffA); PG8_STAGE(PG8_SB(1, 1), cB + hstep + kstep, voffB);
        PG8_WAIT_V(6); PG8_BAR;
    } else {
        PG8_STAGE(PG8_SB(0, 0), cB, voffB); PG8_STAGE(PG8_SA(0, 0), cA, voffA); PG8_STAGE(PG8_SB(0, 1), cB + hstep, voffB); PG8_STAGE(PG8_SA(0, 1), cA + hstep, voffA);
        if (wr == 1) PG8_BAR;
        PG8_WAIT_V(4); PG8_BAR;
        PG8_STAGE(PG8_SB(1, 0), cB + kstep, voffB); PG8_STAGE(PG8_SA(1, 0), cA + kstep, voffA); PG8_STAGE(PG8_SB(1, 1), cB + hstep + kstep, voffB);
        PG8_WAIT_V(6); PG8_BAR;
    }
    for (;;) {
        const bool has_next = S.next(ui + 1, nxt);
        const char* nA = has_next ? (const char*)g.A + (size_t)nxt.pm * tstep : cA; const char* nB = has_next ? (const char*)g.Bt + (size_t)nxt.pn * tstep : cB;
        for (int t = 0; t < nt; t += 2) {
            const bool last = (t == nt - 2);
            const char* a1 = cA + (size_t)(t + 1) * kstep;
            const char* a2 = last ? nA : cA + (size_t)(t + 2) * kstep; const char* b2 = last ? nB : cB + (size_t)(t + 2) * kstep;
            const char* a3 = a2 + kstep; const char* b3 = b2 + kstep;
            if (last && has_next) S.a_ready(nxt);
            if constexpr (SP2) {
            PG8_LDB(B0, 0, 0); PG8_LDB(B1, 0, 1); PG8_SCHED; PG8_LDA(At, 0, 0); PG8_STAGE(PG8_SA(1, 1), a1 + hstep, voffA);
            PG8_WAIT_V(8); PG8_WAIT_L(0); PG8_BAR; PG8_MMA(0, 0, At, B0); PG8_MMA(0, 1, At, B1); PG8_BAR; PG8_SCHED;
            PG8_LDA(At, 0, 1); PG8_STAGE(PG8_SB(0, 0), b2, voffB); PG8_STAGE(PG8_SB(0, 1), b2 + hstep, voffB); PG8_STAGE(PG8_SA(0, 0), a2, voffA);
            PG8_WAIT_V(8); PG8_WAIT_L(0); PG8_BAR; PG8_MMA(1, 0, At, B0); PG8_MMA(1, 1, At, B1); PG8_BAR; PG8_SCHED;
            PG8_LDB(B0, 1, 0); PG8_LDB(B1, 1, 1); PG8_SCHED; PG8_LDA(At, 1, 0); PG8_STAGE(PG8_SA(0, 1), a2 + hstep, voffA);
            PG8_WAIT_V(8); PG8_WAIT_L(0); PG8_BAR; PG8_MMA(0, 0, At, B0); PG8_MMA(0, 1, At, B1); PG8_BAR; PG8_SCHED;
            PG8_LDA(At, 1, 1); PG8_STAGE(PG8_SB(1, 0), b3, voffB); PG8_STAGE(PG8_SB(1, 1), b3 + hstep, voffB); PG8_STAGE(PG8_SA(1, 0), a3, voffA);
            PG8_WAIT_V(8); PG8_WAIT_L(0); PG8_BAR; PG8_MMA(1, 0, At, B0); PG8_MMA(1, 1, At, B1); PG8_BAR; PG8_SCHED;
            } else {
            PG8_LDB(B0, 0, 0); PG8_SCHED; PG8_LDA(At, 0, 0); PG8_STAGE(PG8_SA(1, 1), a1 + hstep, voffA);
            PG8_WAIT_L(8); PG8_BAR; PG8_WAIT_L(0); PG8_MMA(0, 0, At, B0); PG8_BAR; PG8_SCHED;
            PG8_LDB(B1, 0, 1); PG8_STAGE(PG8_SB(0, 0), b2, voffB);
            PG8_BAR; PG8_WAIT_L(0); PG8_MMA(0, 1, At, B1); PG8_BAR;
            PG8_LDA(At, 0, 1); PG8_STAGE(PG8_SA(0, 0), a2, voffA);
            PG8_BAR; PG8_WAIT_L(0); PG8_MMA(1, 0, At, B0); PG8_BAR; PG8_SCHED;
            PG8_STAGE(PG8_SB(0, 1), b2 + hstep, voffB);
            PG8_WAIT_V(6); PG8_BAR; PG8_MMA(1, 1, At, B1); PG8_BAR;
            PG8_LDB(B0, 1, 0); PG8_SCHED; PG8_LDA(At, 1, 0); PG8_STAGE(PG8_SA(0, 1), a2 + hstep, voffA);
            PG8_WAIT_L(8); PG8_BAR; PG8_WAIT_L(0); PG8_MMA(0, 0, At, B0); PG8_BAR; PG8_SCHED;
            PG8_LDB(B1, 1, 1); PG8_STAGE(PG8_SB(1, 0), b3, voffB);
            PG8_BAR; PG8_WAIT_L(0); PG8_MMA(0, 1, At, B1); PG8_BAR;
            PG8_LDA(At, 1, 1); PG8_STAGE(PG8_SA(1, 0), a3, voffA);
            PG8_BAR; PG8_WAIT_L(0); PG8_MMA(1, 0, At, B0); PG8_BAR; PG8_SCHED;
            PG8_STAGE(PG8_SB(1, 1), b3 + hstep, voffB);
            PG8_WAIT_V(6); PG8_BAR; PG8_MMA(1, 1, At, B1); PG8_BAR;
            }
        }
        if constexpr (ALIGN_EPI) { if (wr == 0) PG8_BAR; }
        if constexpr (!Epi::AFTER_DRAIN) { E(acc, cur, wr, wc, fr, fq); S.done(cur); }
        if (!has_next) break;
#pragma unroll
        for (int a = 0; a < 2; ++a)
#pragma unroll
            for (int b = 0; b < 2; ++b)
#pragma unroll
                for (int m = 0; m < 4; ++m)
#pragma unroll
                    for (int n = 0; n < 2; ++n) acc[a][b][m][n] = (f32x4){0.f, 0.f, 0.f, 0.f};
        cur = nxt; cA = nA; cB = nB; ++ui;
        if constexpr (ALIGN_EPI) { if (wr == 1) PG8_BAR; }
    }
    PG8_WAIT_V(0);
    if constexpr (!ALIGN_EPI) { if (wr == 0) PG8_BAR; }
    PG8_BAR;
    if constexpr (Epi::AFTER_DRAIN) { E.fused(acc, cur, wr, wc, fr, fq, lds, wid, lane); S.done(cur); }
#undef PG8_SA
#undef PG8_SB
#undef PG8_STAGE
#undef PG8_LDA
#undef PG8_LDB
#undef PG8_MMA
#undef PG8_WAIT_V
#undef PG8_WAIT_L
#undef PG8_BAR
#undef PG8_SCHED
}
}

#ifndef PG8_SP2
#define PG8_SP2 true
#endif
#ifndef PG8_ALIGN
#define PG8_ALIGN true
#endif
namespace pg8 {
struct EpiF32 {
    static constexpr bool PERM = false, AFTER_DRAIN = false;
    float* O; int ldc;
    __device__ __forceinline__ void operator()(const f32x4 (&acc)[2][2][4][2], const Unit& u, int wr, int wc, int fr, int fq) const {
        const int col0 = u.pn * BM + wc * 32 + 4 * fq;
#pragma unroll
        for (int ai = 0; ai < 2; ++ai)
#pragma unroll
            for (int m = 0; m < 4; ++m) { float* rowp = O + (size_t)(u.pm * BM + ai * HALF + wr * 64 + m * 16 + fr) * ldc + col0;
#pragma unroll
                for (int bj = 0; bj < 2; ++bj)
#pragma unroll
                    for (int n = 0; n < 2; ++n) *(f32x4*)(rowp + bj * HALF + n * 16) = acc[ai][bj][m][n]; }
    }
};
}


namespace attn_body {
using bf16=__hip_bfloat16;
using bf16x8=__attribute__((ext_vector_type(8)))short;
using s16x4=__attribute__((ext_vector_type(4)))short;
using f32x16=__attribute__((ext_vector_type(16)))float;
using u32x4=__attribute__((ext_vector_type(4)))unsigned;
constexpr int BATCH=4,NHEAD=16,SEQ=4096,D=64,DM=NHEAD*D;
constexpr int NW=8,QBLK=32,QB=QBLK*NW,KVBLK=64,NQB=SEQ/QB;
constexpr int ATTN_PITCH=DM, ATTN_UNIT_ROWS=QB;
__device__ __forceinline__ int crow(int r,int hi){return (r&3)+8*(r>>2)+4*hi;}
#define SBAR() __builtin_amdgcn_sched_barrier(0)
__device__ __forceinline__ void cmask(f32x16&p0,f32x16&p1,int jb,int qrel,int hi){
  const float NEG=-INFINITY; int kb=64*jb+4*hi;
  #pragma unroll
  for(int r=0;r<16;++r){int kv=kb+(r&3)+8*(r>>2); if(kv>qrel)p0[r]=NEG; if(kv+32>qrel)p1[r]=NEG;}
}

constexpr int NSLOT=3, SLOTB=8192;
constexpr int LDS_K=0, LDS_V=NSLOT*SLOTB, LDS_WS=2*NSLOT*SLOTB, LDS_OST=LDS_WS+NW*64*4, LDS_BI=LDS_OST+NW*4096, SLOTBI=2048, LDS_BYTES=LDS_BI+NSLOT*SLOTBI;
constexpr float C2=0.125f*1.4426950408889634f;
__device__ __forceinline__ void glds16(const void*gsrc,unsigned lds_dst){unsigned keep;
  asm volatile("s_mov_b32 %0, m0\n\ts_mov_b32 m0, %2\n\ts_nop 0\n\tglobal_load_lds_dwordx4 %1, off\n\ts_mov_b32 m0, %0":"=&s"(keep):"v"(gsrc),"s"(lds_dst):"memory");}
__device__ __forceinline__ void glds4(const void*gsrc,unsigned lds_dst){unsigned keep;
  asm volatile("s_mov_b32 %0, m0\n\ts_mov_b32 m0, %2\n\ts_nop 0\n\tglobal_load_lds_dword %1, off\n\ts_mov_b32 m0, %0":"=&s"(keep):"v"(gsrc),"s"(lds_dst):"memory");}
__device__ __forceinline__ float max3f(float a,float b,float c){float r;asm("v_max3_f32 %0, %1, %2, %3":"=v"(r):"v"(a),"v"(b),"v"(c));return r;}
__device__ __forceinline__ float max2f(float a,float b){float r;asm("v_max_f32_e32 %0, %1, %2":"=v"(r):"v"(a),"v"(b));return r;}
__device__ __forceinline__ float fadd_s(float a,float b){float r;asm("v_add_f32_e32 %0, %1, %2":"=v"(r):"v"(a),"v"(b));return r;}
__device__ __forceinline__ float fsub_s(float a,float b){float r;asm("v_sub_f32_e32 %0, %1, %2":"=v"(r):"v"(a),"v"(b));return r;}
typedef float f32x2_t __attribute__((ext_vector_type(2))); typedef __bf16 bf16x2_t __attribute__((ext_vector_type(2)));
__device__ __forceinline__ unsigned cvtpk_s(float lo,float hi){f32x2_t v={lo,hi};bf16x2_t b=__builtin_convertvector(v,bf16x2_t);return __builtin_bit_cast(unsigned,b);}
#define WAIT_BAR(N) asm volatile("s_waitcnt vmcnt(" #N ") lgkmcnt(0)\n\ts_barrier":::"memory")

template<bool BIAS> __device__ __forceinline__ void qkt(f32x16&p0,f32x16&p1,const char*Kslot,const bf16x8*qr,const f32x16&negm,int r32,int hi,bf16x8 kb0,bf16x8 kb1,bf16x8 qones){
  const char*kb=Kslot+hi*1024+r32*16;
  #pragma unroll
  for(int d0=0;d0<4;++d0){
    const bf16x8 b0=*reinterpret_cast<const bf16x8*>(kb+d0*2048);
    const bf16x8 b1=*reinterpret_cast<const bf16x8*>(kb+d0*2048+512);
    if(d0==0){ if(BIAS){const f32x16 z=f32x16{};p0=__builtin_amdgcn_mfma_f32_32x32x16_bf16(b0,qr[0],z,0,0,0);p1=__builtin_amdgcn_mfma_f32_32x32x16_bf16(b1,qr[0],z,0,0,0);}
      else{p0=__builtin_amdgcn_mfma_f32_32x32x16_bf16(b0,qr[0],negm,0,0,0);p1=__builtin_amdgcn_mfma_f32_32x32x16_bf16(b1,qr[0],negm,0,0,0);} }
    else{p0=__builtin_amdgcn_mfma_f32_32x32x16_bf16(b0,qr[d0],p0,0,0,0);p1=__builtin_amdgcn_mfma_f32_32x32x16_bf16(b1,qr[d0],p1,0,0,0);}}
  if(BIAS){p0=__builtin_amdgcn_mfma_f32_32x32x16_bf16(kb0,qones,p0,0,0,0);p1=__builtin_amdgcn_mfma_f32_32x32x16_bf16(kb1,qones,p1,0,0,0);}
}
typedef __attribute__((address_space(3))) const char* lds_cptr;
typedef short v4i16_t __attribute__((ext_vector_type(4)));
__device__ __forceinline__ void kload8(bf16x8*kf,lds_cptr kp){
  kf[0]=*(const __attribute__((address_space(3))) bf16x8*)(kp);      kf[1]=*(const __attribute__((address_space(3))) bf16x8*)(kp+512);
  kf[2]=*(const __attribute__((address_space(3))) bf16x8*)(kp+2048); kf[3]=*(const __attribute__((address_space(3))) bf16x8*)(kp+2560);
  kf[4]=*(const __attribute__((address_space(3))) bf16x8*)(kp+4096); kf[5]=*(const __attribute__((address_space(3))) bf16x8*)(kp+4608);
  kf[6]=*(const __attribute__((address_space(3))) bf16x8*)(kp+6144); kf[7]=*(const __attribute__((address_space(3))) bf16x8*)(kp+6656);
}
__device__ __forceinline__ void kload2(bf16x8*kf,lds_cptr kp,int j){ kf[2*j]=*(const __attribute__((address_space(3))) bf16x8*)(kp+j*2048); kf[2*j+1]=*(const __attribute__((address_space(3))) bf16x8*)(kp+j*2048+512); }
__device__ __forceinline__ s16x4 vtr(lds_cptr p){ return __builtin_bit_cast(s16x4,__builtin_amdgcn_ds_read_tr16_b64_v4i16((__attribute__((address_space(3))) v4i16_t*)p)); }
__device__ __forceinline__ float rowmax(const f32x16&p0,const f32x16&p1){
  float a=max3f(p0[0],p0[1],p1[0]),b=max3f(p0[2],p0[3],p1[1]);a=max3f(a,p1[2],p1[3]);
  #pragma unroll
  for(int r=4;r<16;r+=4){a=max3f(a,p0[r],p0[r+1]);b=max3f(b,p0[r+2],p0[r+3]);a=max3f(a,p1[r],p1[r+1]);b=max3f(b,p1[r+2],p1[r+3]);}
  const float m=max2f(a,b);
  auto rr=__builtin_amdgcn_permlane32_swap(__float_as_uint(m),__float_as_uint(m),false,false);
  return max2f(__uint_as_float(rr[0]),__uint_as_float(rr[1]));
}
__device__ __forceinline__ void pv(f32x16*o,int vb,bf16x8 pa0,bf16x8 pa1,bf16x8 pa2,bf16x8 pa3){
  #pragma unroll
  for(int d0=0;d0<2;++d0){s16x4 lo[4],hi[4];
    #pragma unroll
    for(int ks=0;ks<4;++ks){
      asm volatile("ds_read_b64_tr_b16 %0,%1 offset:%c2":"=&v"(lo[ks]):"v"(vb),"i"(d0*4096+ks*1024):"memory");
      asm volatile("ds_read_b64_tr_b16 %0,%1 offset:%c2":"=&v"(hi[ks]):"v"(vb),"i"(d0*4096+ks*1024+512):"memory");}
    asm volatile("s_waitcnt lgkmcnt(0)":::"memory");SBAR();
    #define PK(k) (bf16x8){lo[k][0],lo[k][1],lo[k][2],lo[k][3],hi[k][0],hi[k][1],hi[k][2],hi[k][3]}
    o[d0]=__builtin_amdgcn_mfma_f32_32x32x16_bf16(pa0,PK(0),o[d0],0,0,0);
    o[d0]=__builtin_amdgcn_mfma_f32_32x32x16_bf16(pa1,PK(1),o[d0],0,0,0);
    o[d0]=__builtin_amdgcn_mfma_f32_32x32x16_bf16(pa2,PK(2),o[d0],0,0,0);
    o[d0]=__builtin_amdgcn_mfma_f32_32x32x16_bf16(pa3,PK(3),o[d0],0,0,0);
    #undef PK
  }
}

#ifndef ATTN_STORE16
#define ATTN_STORE16(p,v) (*(u32x4*)(p)=(v))
#endif
template<int THRL,bool BIAS,bool DIFF> __device__ __forceinline__ void attn_unit(int b,int hq,int hv,int qb,const bf16*Q,const bf16*__restrict__ K,const bf16*__restrict__ V,bf16*O,char*shm,const unsigned char*BT,float*S,int combine,float lam){
  int tid_=threadIdx.x; asm volatile("":"+v"(tid_));
  const int tid=tid_,lane=tid&63,r32=lane&31,hi=lane>>5; const int wid=__builtin_amdgcn_readfirstlane(tid>>6);
  const long rowbase=(long)b*SEQ; const int q0=qb*QB;
  const bf16*Qw=Q+(rowbase+q0+wid*QBLK)*DM+hq*D;
  const bf16*Kh=K+rowbase*DM+hq*D,*Vh=V+rowbase*DM+hv*D;
  const unsigned lds0=(unsigned)(uintptr_t)shm;
  float*wsf=(float*)(shm+LDS_WS)+wid*64;
  const bf16*ksrc=Kh+(long)lane*DM+wid*8;
  const bf16*vsrc=Vh+(long)(16*(wid&3)+(lane>>2))*DM+(wid>>2)*32+(lane&3)*8;
  const unsigned kdst=lds0+LDS_K+wid*1024, vdst=lds0+LDS_V+wid*1024;
  #define DMA_K(t,slot) glds16(ksrc+(long)(t)*KVBLK*DM,(unsigned)__builtin_amdgcn_readfirstlane(kdst+(slot)))
  #define DMA_V(t,slot) glds16(vsrc+(long)(t)*KVBLK*DM,(unsigned)__builtin_amdgcn_readfirstlane(vdst+(slot)))
  const unsigned char*bsrc=BT+((long)(b*NHEAD+hq)*SEQ)*32+wid*256+lane*4; const unsigned bdst=lds0+LDS_BI+wid*256;
  #define DMA_B(t,slot) glds4(bsrc+(long)(t)*2048,(unsigned)__builtin_amdgcn_readfirstlane(bdst+((slot)>>2)))
  const lds_cptr bp0=(lds_cptr)shm+LDS_BI+r32*32+hi*16; bf16x8 kb0=bf16x8{},kb1=bf16x8{}; u32x4 qm={0x3F803F80u,0x00003F80u,0u,0u};
  #define qones __builtin_bit_cast(bf16x8,qm)
  #define SETREF() do{ if(BIAS){ const float nm_=-mhat; const unsigned h_=__float_as_uint(nm_)&0xffff0000u; const float r1_=nm_-__uint_as_float(h_); const unsigned m_=__float_as_uint(r1_)&0xffff0000u; const float r2_=r1_-__uint_as_float(m_); \
      qm[1]=0x3F80u|h_; qm[2]=(m_>>16)|(__float_as_uint(r2_)&0xffff0000u); } else { _Pragma("unroll") for(int r=0;r<16;++r)negm[r]=-mhat; asm volatile("":"+v"(negm)); } }while(0)
  #define BLD(slot) do{ if(BIAS){ kb0=*(const __attribute__((address_space(3))) bf16x8*)(bp0+((slot)>>2)); kb1=*(const __attribute__((address_space(3))) bf16x8*)(bp0+((slot)>>2)+1024); } }while(0)
  const int vb0=(int)(lds0+LDS_V)+((lane>>4)&1)*32+(lane&3)*8+(4*hi+((lane&15)>>2))*64;
  const char*Kbase=shm+LDS_K; bf16x8 kf[8];
  const lds_cptr shm3=(lds_cptr)shm; const lds_cptr kp0=shm3+LDS_K+hi*1024+r32*16; const lds_cptr vp0=shm3+LDS_V+((lane>>4)&1)*32+(lane&3)*8+(4*hi+((lane&15)>>2))*64;
  const int NT=(q0+QB)/KVBLK;
  DMA_K(0,0);if(BIAS){DMA_B(0,0);}DMA_V(0,0);DMA_K(1,SLOTB);if(BIAS){DMA_B(1,SLOTB);}
  bf16x8 qr[4];
  #pragma unroll
  for(int d0=0;d0<4;++d0)qr[d0]=*reinterpret_cast<const bf16x8*>(&Qw[(long)r32*DM+d0*16+hi*8]);
  float mhat=0.f,l_reg=0.f;f32x16 o[2];o[0]=f32x16{};o[1]=f32x16{};f32x16 negm=f32x16{}; if(!BIAS){asm volatile("":"+v"(negm));}
  const int qrel=wid*QBLK+r32;
  #define CMASK(P0,P1,t) do{int jb_=(t)-(NT-4); if(DIFF){ if(jb_>(wid>>1)){ _Pragma("unroll") for(int r_=0;r_<16;++r_){P0[r_]=-INFINITY;P1[r_]=-INFINITY;} } } else { if(jb_>=0)cmask(P0,P1,jb_,qrel,hi); } }while(0)
  bool resc=false;
  #define START(P0,P1) do{ const float rm=rowmax(P0,P1); resc=false; \
    { const float dl=rm; mhat=fadd_s(mhat,dl); \
      _Pragma("unroll") for(int r=0;r<16;++r){P0[r]=fsub_s(P0[r],dl);P1[r]=fsub_s(P1[r],dl);} \
      SETREF(); } \
    _Pragma("unroll") for(int r=0;r<16;++r)P0[r]=__builtin_amdgcn_exp2f(P0[r]); }while(0)
  #define RESC() do{ if(resc){ asm volatile("s_waitcnt lgkmcnt(0)":::"memory"); \
      _Pragma("unroll") for(int d_=0;d_<2;++d_) _Pragma("unroll") for(int r=0;r<16;++r)o[d_][r]*=wsf[crow(r,hi)]; } }while(0)
  f32x16 pA0,pA1,pB0,pB1;
  int sl_prev=0,sl_cur=0,sl_next=SLOTB;
  #define ROT() do{sl_prev=sl_cur;sl_cur=sl_next;sl_next=(sl_next==(NSLOT-1)*SLOTB)?0:sl_next+SLOTB;}while(0)
  DMA_K(2,2*SLOTB);
  if(BIAS){WAIT_BAR(4);}else{WAIT_BAR(3);}
  if(BIAS){DMA_B(2,2*SLOTB);BLD(0);}
  qkt<BIAS>(pA0,pA1,Kbase,qr,negm,r32,hi,kb0,kb1,qones);asm volatile("s_nop 15\n\ts_nop 7":"+v"(pA0),"+v"(pA1));CMASK(pA0,pA1,0);
  START(pA0,pA1);
  _Pragma("unroll") for(int r=0;r<16;++r)pA1[r]=__builtin_amdgcn_exp2f(pA1[r]);
  WAIT_BAR(0);
  DMA_K(3,0);DMA_V(1,SLOTB);
  ROT();
  kload8(kf,kp0+sl_cur);
  WAIT_BAR(2);
  s16x4 vlo[8],vhi[8]; u32x4 pw0,pw1,pw2,pw3;
  #define PKW(P,B) cvtpk_s(P[B],P[B+1])
  #define PAF(k) __builtin_bit_cast(bf16x8,pw##k)
  #define VFR(i) (bf16x8){vlo[i][0],vlo[i][1],vlo[i][2],vlo[i][3],vhi[i][0],vhi[i][1],vhi[i][2],vhi[i][3]}
  #define PIN(x) asm volatile("":"+v"(x))
  #define MX3(a,b,c) __builtin_fmaxf(__builtin_fmaxf((a),(b)),(c))
  #define GAPA(MF,A0,A1,A2,A3,W0,W1,PW) do{ MF; sacc+=A0; sacc+=A1; sacc+=A2; sacc+=A3; PIN(sacc); W0; W1; PIN(PW); SBAR(); }while(0)
  #define EX(v) __builtin_amdgcn_exp2f(v)
  #define GAPB(MF,X,B) do{ MF; X[B]=EX(X[B]); X[B+1]=EX(X[B+1]); X[B+2]=EX(X[B+2]); X[B+3]=EX(X[B+3]); PIN(X); SBAR(); }while(0)
  #define VRD(i) do{ vlo[i]=vtr(vp_+(((i)>>2)*4096+((i)&3)*1024)); vhi[i]=vtr(vp_+(((i)>>2)*4096+((i)&3)*1024+512)); }while(0)
  #define KRD(G,j) do{ if(G){ kload2(kf,kp0+sl_next,j); SBAR(); } }while(0)
  #define CINIT (BIAS?f32x16{}:negm)
  #define STEP(C0,C1,P0,P1,t,GK,GV,GL,GB) do{ SBAR(); \
    if(BIAS){ if(GB){DMA_B((t)+2,sl_prev);} BLD(sl_cur); } \
    const lds_cptr vp_=vp0+sl_prev; \
    VRD(0); SBAR(); float sacc=(P0[0]+P0[1]); \
    GAPA(C0=__builtin_amdgcn_mfma_f32_32x32x16_bf16(kf[0],qr[0],CINIT,0,0,0), P0[2],P0[3],P0[4],P0[5],     pw0[0]=PKW(P0,0), pw0[1]=PKW(P0,2), pw0); \
    VRD(4); SBAR(); GAPA(C1=__builtin_amdgcn_mfma_f32_32x32x16_bf16(kf[1],qr[0],CINIT,0,0,0), P0[6],P0[7],P0[8],P0[9],     pw0[2]=PKW(P0,4), pw0[3]=PKW(P0,6), pw0); \
    VRD(1); SBAR(); GAPA(C0=__builtin_amdgcn_mfma_f32_32x32x16_bf16(kf[2],qr[1],C0,0,0,0),   P0[10],P0[11],P0[12],P0[13], pw1[0]=PKW(P0,8), pw1[1]=PKW(P0,10), pw1); \
    VRD(5); SBAR(); GAPA(C1=__builtin_amdgcn_mfma_f32_32x32x16_bf16(kf[3],qr[1],C1,0,0,0),   P0[14],P0[15],P1[0],P1[1],   pw1[2]=PKW(P0,12),pw1[3]=PKW(P0,14), pw1); \
    VRD(2); SBAR(); GAPA(C0=__builtin_amdgcn_mfma_f32_32x32x16_bf16(kf[4],qr[2],C0,0,0,0),   P1[2],P1[3],P1[4],P1[5],     pw2[0]=PKW(P1,0), pw2[1]=PKW(P1,2), pw2); \
    VRD(6); SBAR(); GAPA(C1=__builtin_amdgcn_mfma_f32_32x32x16_bf16(kf[5],qr[2],C1,0,0,0),   P1[6],P1[7],P1[8],P1[9],     pw2[2]=PKW(P1,4), pw2[3]=PKW(P1,6), pw2); \
    VRD(3); SBAR(); GAPA(C0=__builtin_amdgcn_mfma_f32_32x32x16_bf16(kf[6],qr[3],C0,0,0,0),   P1[10],P1[11],P1[12],P1[13], pw3[0]=PKW(P1,8), pw3[1]=PKW(P1,10), pw3); \
    VRD(7); SBAR(); GAPA(C1=__builtin_amdgcn_mfma_f32_32x32x16_bf16(kf[7],qr[3],C1,0,0,0),   P1[14],P1[15],0.f,0.f,       pw3[2]=PKW(P1,12),pw3[3]=PKW(P1,14), pw3); \
    if(BIAS){ C0=__builtin_amdgcn_mfma_f32_32x32x16_bf16(kb0,qones,C0,0,0,0); C1=__builtin_amdgcn_mfma_f32_32x32x16_bf16(kb1,qones,C1,0,0,0); } \
    l_reg+=sacc; \
    if(GK){DMA_K((t)+3,sl_cur);} if(GV){DMA_V((t)+1,sl_next);} \
    CMASK(C0,C1,t); \
    { float a=MX3(C0[0],C0[1],C1[0]),b=MX3(C0[2],C0[3],C1[1]); a=MX3(a,C1[2],C1[3]); \
      _Pragma("unroll") for(int r=4;r<16;r+=4){a=MX3(a,C0[r],C0[r+1]);b=MX3(b,C0[r+2],C0[r+3]);a=MX3(a,C1[r],C1[r+1]);b=MX3(b,C1[r+2],C1[r+3]);} \
      float rm=__builtin_fmaxf(a,b); { auto rr=__builtin_amdgcn_permlane32_swap(__float_as_uint(rm),__float_as_uint(rm),false,false); rm=__builtin_fmaxf(__uint_as_float(rr[0]),__uint_as_float(rr[1])); } \
      resc=false; \
      if(__builtin_expect(__any(rm>(float)THRL),0)){ const float dl=__builtin_fmaxf(rm,0.f); mhat+=dl; \
        _Pragma("unroll") for(int r=0;r<16;++r){C0[r]-=dl;C1[r]-=dl;} \
        SETREF(); \
        const float f=__builtin_amdgcn_exp2f(-dl); l_reg*=f; if(hi==0)wsf[r32]=f; resc=true; } } \
    SBAR(); \
    GAPB(o[0]=__builtin_amdgcn_mfma_f32_32x32x16_bf16(PAF(0),VFR(0),o[0],0,0,0), C0,0); \
    GAPB(o[1]=__builtin_amdgcn_mfma_f32_32x32x16_bf16(PAF(0),VFR(4),o[1],0,0,0), C0,4); \
    KRD(GL,0); GAPB(o[0]=__builtin_amdgcn_mfma_f32_32x32x16_bf16(PAF(1),VFR(1),o[0],0,0,0), C0,8); \
    KRD(GL,1); GAPB(o[1]=__builtin_amdgcn_mfma_f32_32x32x16_bf16(PAF(1),VFR(5),o[1],0,0,0), C0,12); \
    KRD(GL,2); GAPB(o[0]=__builtin_amdgcn_mfma_f32_32x32x16_bf16(PAF(2),VFR(2),o[0],0,0,0), C1,0); \
    KRD(GL,3); GAPB(o[1]=__builtin_amdgcn_mfma_f32_32x32x16_bf16(PAF(2),VFR(6),o[1],0,0,0), C1,4); \
    GAPB(o[0]=__builtin_amdgcn_mfma_f32_32x32x16_bf16(PAF(3),VFR(3),o[0],0,0,0), C1,8); \
    GAPB(o[1]=__builtin_amdgcn_mfma_f32_32x32x16_bf16(PAF(3),VFR(7),o[1],0,0,0), C1,12); \
    }while(0)
  int t=1;
  #undef CMASK
  #define CMASK(P0,P1,t) do{}while(0)
  for(;t+5<NT;t+=2){
    STEP(pB0,pB1,pA0,pA1,t,true,true,true,true);     WAIT_BAR(2); RESC(); ROT();
    STEP(pA0,pA1,pB0,pB1,t+1,true,true,true,true);   WAIT_BAR(2); RESC(); ROT();
  }
  #undef CMASK
  #define CMASK(P0,P1,t) do{int jb_=(t)-(NT-4); if(DIFF){ if(jb_>(wid>>1)){ _Pragma("unroll") for(int r_=0;r_<16;++r_){P0[r_]=-INFINITY;P1[r_]=-INFINITY;} } } else { if(jb_>=0)cmask(P0,P1,jb_,qrel,hi); } }while(0)
  #define ENDW(tt) do{ if((tt)+3<NT){WAIT_BAR(2);} else if((tt)+2<NT){WAIT_BAR(1);} else {WAIT_BAR(0);} }while(0)
  for(;t+1<NT;t+=2){
    STEP(pB0,pB1,pA0,pA1,t,(t+3<NT),(t+1<NT),(t+1<NT),(t+2<NT));       ENDW(t);   RESC(); ROT();
    STEP(pA0,pA1,pB0,pB1,t+1,(t+4<NT),(t+2<NT),(t+2<NT),(t+3<NT));     ENDW(t+1); RESC(); ROT();
  }
  STEP(pB0,pB1,pA0,pA1,NT-1,false,false,false,false); RESC();
  { float sacc=pB0[0]+pB0[1]; _Pragma("unroll") for(int r=2;r<16;++r)sacc+=pB0[r]; _Pragma("unroll") for(int r=0;r<16;++r)sacc+=pB1[r]; l_reg+=sacc;
    pw0=(u32x4){PKW(pB0,0),PKW(pB0,2),PKW(pB0,4),PKW(pB0,6)};pw1=(u32x4){PKW(pB0,8),PKW(pB0,10),PKW(pB0,12),PKW(pB0,14)};pw2=(u32x4){PKW(pB1,0),PKW(pB1,2),PKW(pB1,4),PKW(pB1,6)};pw3=(u32x4){PKW(pB1,8),PKW(pB1,10),PKW(pB1,12),PKW(pB1,14)};
    SBAR(); pv(o,vb0+sl_cur,PAF(0),PAF(1),PAF(2),PAF(3)); }
  #undef PKW
  #undef PAF
  #undef VFR
  #undef PIN
  #undef MX3
  #undef GAPA
  #undef GAPB
  #undef EX
  #undef VRD
  #undef KRD
  #undef STEP
  #undef ENDW
  {auto rr=__builtin_amdgcn_permlane32_swap(__float_as_uint(l_reg),__float_as_uint(l_reg),false,false);l_reg=__uint_as_float(rr[0])+__uint_as_float(rr[1]);}
  if(hi==0)wsf[32+r32]=l_reg;asm volatile("s_waitcnt lgkmcnt(0)":::"memory");
  float rli[16];
  #pragma unroll
  for(int r=0;r<16;++r)rli[r]=__builtin_amdgcn_rcpf(wsf[32+crow(r,hi)]);
  if(DIFF){ float*Sw=S+(rowbase+q0+wid*QBLK)*DM+hv*D;
    #pragma unroll
    for(int r=0;r<16;++r){ float*sp=Sw+(long)crow(r,hi)*DM+r32;
      #pragma unroll
      for(int d0=0;d0<2;++d0){ float v=o[d0][r]*rli[r]; if(combine)v=sp[d0*32]-lam*v; sp[d0*32]=v; } } }
  else { bf16*Ow=O+(rowbase+q0+wid*QBLK)*DM+hq*D;
    bf16*stg=(bf16*)(shm+LDS_OST)+wid*2048;
    #pragma unroll
    for(int r=0;r<16;++r){const int orow=crow(r,hi);
      #pragma unroll
      for(int d0=0;d0<2;++d0)stg[orow*64+d0*32+r32]=__float2bfloat16(o[d0][r]*rli[r]);}
    asm volatile("s_waitcnt lgkmcnt(0)":::"memory");
    #pragma unroll
    for(int i=0;i<4;++i){const int row=i*8+(lane>>3),ch=lane&7; const u32x4 v=*(const u32x4*)(stg+row*64+ch*8); ATTN_STORE16(Ow+(long)row*DM+ch*8,v);} }
  asm volatile("s_waitcnt lgkmcnt(0)\n\ts_barrier":::"memory");
  #undef DMA_K
  #undef DMA_V
  #undef DMA_B
  #undef BLD
  #undef qones
  #undef SETREF
  #undef CINIT
  #undef CMASK
  #undef START
  #undef RESC
  #undef ROT
}
constexpr int ATTN_LDS_BYTES=LDS_BYTES;
struct AttnTensors { const bf16* Q; const bf16* K; const bf16* V; bf16* O; };
struct AttnUnit { int bh; int qb; };
struct StaticOrder {
  int vcu;
  __device__ __forceinline__ explicit StaticOrder(int grid,int block):vcu((block%8)*(grid/8)+block/8){}
  __device__ __forceinline__ bool next(int i,AttnUnit&u)const{ if(i>=4)return false; const int s=vcu&3; u.bh=vcu>>2; u.qb=(i==0)?s:(i==1)?7-s:(i==2)?8+s:15-s; return true; }
  __device__ __forceinline__ void a_ready(const AttnUnit&)const{}
  __device__ __forceinline__ void done(const AttnUnit&)const{}
};
template<class Sched,int THRL,bool BIAS> __device__ __forceinline__ void attn_phase(char*lds,const AttnTensors&T,const Sched&S,const unsigned char*BT){
  AttnUnit u;
  for(int i=0;S.next(i,u);++i){ S.a_ready(u); attn_unit<THRL,BIAS,false>(u.bh/NHEAD,u.bh%NHEAD,u.bh%NHEAD,u.qb,T.Q,T.K,T.V,T.O,lds,BT,nullptr,0,0.f); S.done(u); }
}
template<int THRL> __device__ __forceinline__ void diff_phase(char*lds,const bf16*Q1,const bf16*K12,const bf16*V,float*S,float lam,int grid,int block){
  const int vcu=(block%8)*(grid/8)+block/8, s=vcu&7, bh=vcu>>3, b=bh>>3, h8=bh&7;
  for(int ui=0;ui<2;++ui){ const int qb=ui==0?s:15-s;
    for(int ps=0;ps<4;++ps){ const int i=ps&1, j=ps>>1; attn_unit<THRL,false,true>(b,i*8+h8,2*h8+j,qb,Q1,K12,V,nullptr,lds,nullptr,S,i,lam); } }
}
#undef SBAR
#undef WAIT_BAR
}
#define GAS __attribute__((address_space(1)))
#define LAS __attribute__((address_space(3)))
typedef unsigned short bf16;
typedef unsigned v4u __attribute__((ext_vector_type(4)));
typedef float f32x4 __attribute__((ext_vector_type(4)));
typedef short bf16x8 __attribute__((ext_vector_type(8)));
typedef GAS unsigned gu32;
typedef GAS unsigned long long gu64;
#define RLX_AGENT __ATOMIC_RELAXED, __HIP_MEMORY_SCOPE_AGENT
#define LDS_WAIT() asm volatile("s_waitcnt lgkmcnt(0)" ::: "memory")
#define VM_WAIT() asm volatile("s_waitcnt vmcnt(0)" ::: "memory")
__device__ __forceinline__ unsigned long long rt() { return __builtin_amdgcn_s_memrealtime(); }
__device__ __forceinline__ unsigned f2bf(float f) { unsigned u = __builtin_bit_cast(unsigned, f); return (u + 0x7fffu + ((u >> 16) & 1u)) >> 16; }
__device__ __forceinline__ unsigned pk2(float lo, float hi) { return f2bf(lo) | (f2bf(hi) << 16); }

#define XB_TMO      128
#define XB_XCNT(j)  (256  + 64 * (j))
#define XB_XSUB(j)  (1280 + 64 * (j))
#define XB_XGEN(j)  (2304 + 64 * (j))
#define XB_TOP      3328
#define XB_TOPGEN   3392
#define XCD_BAR_WORDS 3456
#define XB_SPIN_CAP (1u << 18)

__device__ __forceinline__ unsigned xb_ld(unsigned* p)              { return __hip_atomic_load(p, __ATOMIC_RELAXED, __HIP_MEMORY_SCOPE_AGENT); }
__device__ __forceinline__ unsigned xb_add(unsigned* p, unsigned v) { return __hip_atomic_fetch_add(p, v, __ATOMIC_RELAXED, __HIP_MEMORY_SCOPE_AGENT); }
__device__ __forceinline__ unsigned xb_xcc_id() { return (unsigned)__builtin_amdgcn_s_getreg((3 << 11) | 20) & 0xFu; }
#define XB_SPIN(cond, bar) do { unsigned _sp = 0; while (cond) { __builtin_amdgcn_s_sleep(1); \
    if ((++_sp & 255u) == 0u) { if (xb_ld(&(bar)[XB_TMO])) break; if (_sp > XB_SPIN_CAP) { atomicAdd(&(bar)[XB_TMO], 1u); break; } } } } while (0)

struct XcdBarrier {
    unsigned* bar; unsigned x;
    volatile LAS unsigned* st;
};

__device__ __forceinline__ XcdBarrier xcd_barrier_post(unsigned* bar, volatile LAS unsigned* st) {
    XcdBarrier b; b.bar = bar; b.x = xb_xcc_id(); b.st = st;
    if (threadIdx.x == 0) (void)xb_add(&bar[XB_XCNT(b.x)], 1u);
    return b;
}
__device__ __forceinline__ void xcd_barrier_complete(unsigned* bar, unsigned x, unsigned& nloc, unsigned& nx) {
    const unsigned G = gridDim.x * gridDim.y * gridDim.z;
    unsigned sum, cnt, mine, sp = 0u;
    for (;;) {
        sum = 0u; cnt = 0u; mine = 0u;
#pragma unroll
        for (unsigned j = 0; j < 16; ++j) { const unsigned c = xb_ld(&bar[XB_XCNT(j)]); sum += c; cnt += (c > 0u) ? 1u : 0u; mine = (j == x) ? c : mine; }
        if (sum == G) break;
        __builtin_amdgcn_s_sleep(1);
        if ((++sp & 255u) == 0u) { if (xb_ld(&bar[XB_TMO])) break; if (sp > XB_SPIN_CAP) { atomicAdd(&bar[XB_TMO], 1u); break; } }
    }
    nloc = mine > 0u ? mine : 1u; nx = cnt > 0u ? cnt : 1u;
}

__device__ __forceinline__ void xcd_barrier(const XcdBarrier& b) {
    asm volatile("s_waitcnt vmcnt(0)" ::: "memory");
    __syncthreads();
    if (threadIdx.x == 0) {
        unsigned* bar = b.bar;
        __builtin_amdgcn_s_waitcnt(0);
        unsigned nloc = b.st[0], nx = b.st[1];
        if (nloc == 0u) { xcd_barrier_complete(bar, b.x, nloc, nx); b.st[0] = nloc; b.st[1] = nx; }
        const unsigned old = xb_add(&bar[XB_XSUB(b.x)], 1u);
        const unsigned gen = old / nloc;
        if (old + 1u == (gen + 1u) * nloc) {
            __builtin_amdgcn_fence(__ATOMIC_RELEASE, "agent");
            asm volatile("s_waitcnt vmcnt(0)" ::: "memory");
            const unsigned og = xb_add(&bar[XB_TOP], 1u);
            const unsigned tg = og / nx;
            if (og + 1u == (tg + 1u) * nx) xb_add(&bar[XB_TOPGEN], 1u);
            else XB_SPIN(xb_ld(&bar[XB_TOPGEN]) == tg, bar);
            __builtin_amdgcn_fence(__ATOMIC_ACQUIRE, "agent");
            xb_add(&bar[XB_XGEN(b.x)], 1u);
            asm volatile("s_waitcnt vmcnt(0)" ::: "memory");
        } else {
            XB_SPIN(xb_ld(&bar[XB_XGEN(b.x)]) == gen, bar);
            __builtin_amdgcn_fence(__ATOMIC_ACQUIRE, "agent");
            asm volatile("s_waitcnt vmcnt(0)" ::: "memory");
        }
    }
    __syncthreads();
}
constexpr int NWAVES = 8;
constexpr int BATCH = 4, SEQ = 4096, D = 1024, NH = 16, HD = 64, FF = 2816, FF2 = 2 * FF, DH2 = 8, DV = 128;
constexpr int M = BATCH * SEQ;
constexpr int AWIN_LD = 3 * D + NH;
constexpr float LN_EPS = 1e-5f, RMS_EPS = 1e-5f;
constexpr float DN_ALPHA = 1.4142135623730951f;
constexpr float LAMBDA_INIT = 0.35550906759096926f;
constexpr float C2 = 0.125f * 1.4426950408889634f;
constexpr float LOG2E = 1.4426950408889634f;

constexpr size_t MiB = 1u << 20;
constexpr size_t WS_CTL = 0, CTL_ZERO_BYTES = 1 * MiB;
constexpr size_t WS_COS = 1 * MiB, WS_SIN = WS_COS + 512 * 1024;
constexpr size_t WS_FLOG = 2 * MiB;
constexpr size_t WS_CK = 3 * MiB;
constexpr size_t WS_X = 5 * MiB;
constexpr size_t WS_WQKV0 = 8 * MiB, WS_WO0 = 14 * MiB, WS_WQKV1 = 16 * MiB, WS_WO1 = 22 * MiB;
constexpr size_t WS_WIN0 = 24 * MiB, WS_WIN1 = 35 * MiB, WS_WOUT0 = 46 * MiB, WS_WOUT1 = 52 * MiB;
constexpr size_t WS_XB = 58 * MiB;
constexpr size_t WS_QO = 90 * MiB, WS_KB = 122 * MiB, WS_VB = 154 * MiB;
constexpr size_t WS_BT = 186 * MiB;
constexpr size_t WS_HS = 186 * MiB;
constexpr size_t WS_UH = 90 * MiB;
constexpr size_t WS_HH = 178 * MiB;
constexpr size_t WS_HSH = 222 * MiB;
constexpr size_t WS_END = 256 * MiB;
static_assert(WS_UH + (size_t)(M / 2) * FF2 * 2 <= WS_HH && WS_HH + (size_t)(M / 2) * FF * 2 <= WS_HSH && WS_HSH + (size_t)(M / 2) * D * 4 <= WS_END, "ffn map");
static_assert(WS_HS + (size_t)M * D * 4 <= WS_END && WS_VB + (size_t)M * D * 2 <= WS_HS && WS_XB + (size_t)M * D * 2 <= WS_QO, "attn map");
constexpr int CW_TMO = 0, CW_CODE = 1, CW_BAR = 4096, CW_SEAM = 16384, SEAM_BANK = 128 * 64;

constexpr int RING_OFF = 0, RING_BYTES = 131072;
constexpr int LDSCTL_OFF = RING_BYTES, MISC_OFF = LDSCTL_OFF + 320;
constexpr int LDS_BYTES = 147456;

struct Frame {
    LAS unsigned char* lds;
    volatile LAS unsigned* MISC;
    gu32* ctl;
    int tid, lane, wave;
    int vcu, G;
};
struct Args { const float* in[17]; float* out; unsigned char* ws; int ph_lo, ph_hi; };

__device__ __forceinline__ float wave_sum(float v) {
#pragma unroll
    for (int o = 1; o < 64; o <<= 1) v += __shfl_xor(v, o);
    return v;
}
__device__ __forceinline__ float bf2f(unsigned short h) { return __uint_as_float((unsigned)h << 16); }

__device__ __forceinline__ int map_row(int mode, int off, int n) {
    if (mode == 1) {
        const int g = n & ~63, d = n & 63;
        const int p = d < 32 ? 8 * (d >> 2) + (d & 3) : 8 * ((d - 32) >> 2) + 4 + (d & 3);
        return off + g + p;
    }
    if (mode == 2) {
        return n < FF ? 256 * (n >> 7) + (n & 127) : 256 * ((n - FF) >> 7) + 128 + ((n - FF) & 127);
    }
    return off + n;
}
__device__ __forceinline__ void p0_transpose_item(const float* W, int ldw, int K, int nblk, bf16* WT, int mode, int off, LAS float* scr, int item, int lane) {
    const int kb = item / nblk, nb = item % nblk, k0 = 64 * kb, n0 = 32 * nb;
#pragma unroll 8
    for (int i = 0; i < 32; ++i) { const int kk = 2 * i + (lane >> 5); scr[kk * 33 + (lane & 31)] = W[(size_t)(k0 + kk) * ldw + n0 + (lane & 31)]; }
    LDS_WAIT(); asm volatile("" ::: "memory");
    const int c = lane & 7;
#pragma unroll
    for (int j = 0; j < 4; ++j) { const int n = (lane >> 3) + 8 * j; const LAS float* s = scr + (8 * c) * 33 + n;
        v4u o; o.x = pk2(s[0 * 33], s[1 * 33]); o.y = pk2(s[2 * 33], s[3 * 33]); o.z = pk2(s[4 * 33], s[5 * 33]); o.w = pk2(s[6 * 33], s[7 * 33]);
        *(GAS v4u*)(WT + (size_t)map_row(mode, off, n0 + n) * K + k0 + 8 * c) = o; }
    LDS_WAIT(); asm volatile("" ::: "memory");
}
__device__ __forceinline__ void sincos_d(double x, double& s, double& c) {
    const double n = __builtin_rint(x * 0.63661977236758134308);
    double r = __builtin_fma(-n, 1.57079632679489655800, x); r = __builtin_fma(-n, 6.12323399573676603587e-17, r);
    const double r2 = r * r;
    double sp = -7.6471637318198164759e-13; sp = __builtin_fma(sp, r2, 1.6059043836821614599e-10); sp = __builtin_fma(sp, r2, -2.5052108385441718775e-08);
    sp = __builtin_fma(sp, r2, 2.7557319223985890653e-06); sp = __builtin_fma(sp, r2, -1.9841269841269841270e-04); sp = __builtin_fma(sp, r2, 8.3333333333333333333e-03);
    sp = __builtin_fma(sp, r2, -1.6666666666666666667e-01); const double sr = __builtin_fma(sp * r2, r, r);
    double cp = 4.7794773323873852974e-14; cp = __builtin_fma(cp, r2, -1.1470745597729724714e-11); cp = __builtin_fma(cp, r2, 2.0876756987868098979e-09);
    cp = __builtin_fma(cp, r2, -2.7557319223985890653e-07); cp = __builtin_fma(cp, r2, 2.4801587301587301587e-05); cp = __builtin_fma(cp, r2, -1.3888888888888888889e-03);
    cp = __builtin_fma(cp, r2, 4.1666666666666666667e-02); cp = __builtin_fma(cp, r2, -0.5); const double cr = __builtin_fma(cp, r2, 1.0);
    const int q = ((int)n) & 3;
    s = (q == 0) ? sr : (q == 1) ? cr : (q == 2) ? -sr : -cr;
    c = (q == 0) ? cr : (q == 1) ? -sr : (q == 2) ? -cr : sr;
}

__device__ __forceinline__ void p0_prologue(Frame& F, const Args& args) {
    unsigned char* ws = args.ws;
    LAS float* scr = (LAS float*)(F.lds + RING_OFF + F.wave * 16384);
    const int gw = F.vcu * NWAVES + F.wave, NGW = F.G * NWAVES;
    constexpr int I0 = 16 * 96, I1 = 16 * 32, I7 = 16 * 176, I9 = 44 * 32;
    constexpr int NITEMS = I0 + 5 * I1 + 2 * I7 + 2 * I9;
    for (int it = gw; it < NITEMS; it += NGW) {
        int r = it; const float* W; int ldw, K, nblk, mode = 0, off = 0; size_t dst;
        if (r < I0) { W = args.in[1]; ldw = AWIN_LD; K = D; nblk = 96; dst = WS_WQKV0; }
        else if ((r -= I0) < I1) { W = args.in[3]; ldw = D; K = D; nblk = 32; dst = WS_WO0; }
        else if ((r -= I1) < I1) { W = args.in[5]; ldw = D; K = D; nblk = 32; dst = WS_WQKV1; mode = 1; }
        else if ((r -= I1) < I1) { W = args.in[4]; ldw = 2 * D; K = D; nblk = 32; dst = WS_WQKV1; mode = 1; off = D; }
        else if ((r -= I1) < I1) { W = args.in[4] + D; ldw = 2 * D; K = D; nblk = 32; dst = WS_WQKV1; off = 2 * D; }
        else if ((r -= I1) < I1) { W = args.in[8]; ldw = D; K = D; nblk = 32; dst = WS_WO1; }
        else if ((r -= I1) < I7) { W = args.in[9]; ldw = FF2; K = D; nblk = 176; dst = WS_WIN0; mode = 2; }
        else if ((r -= I7) < I7) { W = args.in[9] + (size_t)D * FF2; ldw = FF2; K = D; nblk = 176; dst = WS_WIN1; mode = 2; }
        else if ((r -= I7) < I9) { W = args.in[12]; ldw = D; K = FF; nblk = 32; dst = WS_WOUT0; }
        else { r -= I9; W = args.in[12] + (size_t)FF * D; ldw = D; K = FF; nblk = 32; dst = WS_WOUT1; }
        p0_transpose_item(W, ldw, K, nblk, (bf16*)(ws + dst), mode, off, scr, r, F.lane);
    }
    {
        float* cosT = (float*)(ws + WS_COS); float* sinT = (float*)(ws + WS_SIN);
        for (int e = (int)blockIdx.x * (NWAVES * 64) + F.tid; e < SEQ * 32; e += F.G * NWAVES * 64) {
            const int pos = e >> 5, i = e & 31;
            double invd = 1.0; for (int q_ = 0; q_ < i; ++q_) invd *= 0.7498942093324559;
            const float inv = (float)invd;
            const float ang = (float)pos * inv;
            double s, c; sincos_d((double)ang, s, c);
            cosT[e] = (float)c; sinT[e] = (float)s;
        }
    }
    __syncthreads();
    {
        LAS float* wf = (LAS float*)(F.lds + RING_OFF);
        const float* Win = args.in[1];
        for (int e = F.tid; e < 16 * D; e += NWAVES * 64) { const int k = e >> 4, h = e & 15; wf[h * D + k] = Win[(size_t)k * AWIN_LD + 3 * D + h]; }
        __syncthreads();
        const float* x = args.in[0]; bf16* XB = (bf16*)(ws + WS_XB); float* flog = (float*)(ws + WS_FLOG); const float* bfv = args.in[2];
        for (int m = gw; m < M; m += NGW) {
            const GAS f32x4* xr = (const GAS f32x4*)(x + (size_t)m * D) + F.lane;
            f32x4 v[4];
#pragma unroll
            for (int j = 0; j < 4; ++j) v[j] = xr[64 * j];
            GAS unsigned long long* o8 = (GAS unsigned long long*)(XB + (size_t)m * D) + F.lane;
#pragma unroll
            for (int j = 0; j < 4; ++j) o8[64 * j] = (unsigned long long)pk2(v[j].x, v[j].y) | ((unsigned long long)pk2(v[j].z, v[j].w) << 32);
            float mine = 0.f;
#pragma unroll 2
            for (int h = 0; h < 16; ++h) {
                float a = 0.f;
#pragma unroll
                for (int j = 0; j < 4; ++j) { const f32x4 w = *(const LAS f32x4*)(wf + h * D + 256 * j + 4 * F.lane); a += (v[j].x * w.x + v[j].y * w.y) + (v[j].z * w.z + v[j].w * w.w); }
                a = wave_sum(a);
                if (F.lane == h) mine = a;
            }
            if (F.lane < 16) flog[(size_t)m * 16 + F.lane] = mine + bfv[F.lane];
        }
    }
    __syncthreads();
}

__device__ __forceinline__ void scan_phase(Frame& F, const Args& args) {
    if (blockIdx.x >= BATCH * NH) return;
    const int bh = blockIdx.x, b = bh >> 4, h = bh & 15;
    const float* flog = (const float*)(args.ws + WS_FLOG); double* ck = (double*)(args.ws + WS_CK) + (size_t)bh * SEQ;
    LAS double* wtot = (LAS double*)(F.lds + RING_OFF);
    double loc[8]; double run = 0.0;
#pragma unroll
    for (int e = 0; e < 8; ++e) {
        const float f = flog[(size_t)(b * SEQ + F.tid * 8 + e) * 16 + h];
        const float ls = fminf(f, 0.f) - log1pf(expf(-fabsf(f)));
        run += (double)ls * 1.4426950408889634; loc[e] = run;
    }
    double inc = run;
#pragma unroll
    for (int o = 1; o < 64; o <<= 1) { const double t = __shfl_up(inc, o); if (F.lane >= o) inc += t; }
    if (F.lane == 63) wtot[F.wave] = inc;
    __syncthreads();
    double base = inc - run;
    for (int w = 0; w < F.wave; ++w) base += wtot[w];
    v4u* bt = (v4u*)(args.ws + WS_BT) + ((size_t)bh * SEQ + F.tid * 8) * 2;
#pragma unroll
    for (int e = 0; e < 8; ++e) {
        const double v = -(base + loc[e]);
        ck[F.tid * 8 + e] = base + loc[e];
        const unsigned hi = f2bf((float)v); const double r1 = v - (double)__uint_as_float(hi << 16);
        const unsigned mid = f2bf((float)r1); const double r2 = r1 - (double)__uint_as_float(mid << 16);
        const unsigned lo = f2bf((float)r2);
        bt[2 * e] = (v4u){hi | (mid << 16), lo | 0x3F800000u, 0x3F803F80u, 0u}; bt[2 * e + 1] = (v4u){0u, 0u, 0u, 0u};
    }
    __syncthreads();
}

__device__ __forceinline__ void ln_phase(Frame& F, const float* xin, const float* hs, const float* g, const float* bta, float* xout, bf16* xb, int row0, int nrows) {
    const int gw = F.vcu * NWAVES + F.wave, NGW = F.G * NWAVES;
    for (int r = gw; r < nrows; r += NGW) {
        const int m = row0 + r;
        const GAS f32x4* xr = (const GAS f32x4*)(xin + (size_t)m * D) + F.lane;
        const GAS f32x4* hr = (const GAS f32x4*)(hs + (size_t)r * D) + F.lane;
        f32x4 v[4]; float s = 0.f;
#pragma unroll
        for (int j = 0; j < 4; ++j) { v[j] = xr[64 * j] * DN_ALPHA + hr[64 * j]; s += (v[j].x + v[j].y) + (v[j].z + v[j].w); }
        const float mean = wave_sum(s) * (1.f / D); float s2 = 0.f;
#pragma unroll
        for (int j = 0; j < 4; ++j) { v[j] = v[j] - mean; s2 += (v[j].x * v[j].x + v[j].y * v[j].y) + (v[j].z * v[j].z + v[j].w * v[j].w); }
        const float rstd = 1.f / sqrtf(wave_sum(s2) * (1.f / D) + LN_EPS);
        GAS f32x4* xo = (GAS f32x4*)(xout + (size_t)m * D) + F.lane;
        GAS unsigned long long* o8 = (GAS unsigned long long*)(xb + (size_t)m * D) + F.lane;
#pragma unroll
        for (int j = 0; j < 4; ++j) {
            const f32x4 gg = *((const GAS f32x4*)g + F.lane + 64 * j), bb = *((const GAS f32x4*)bta + F.lane + 64 * j);
            const f32x4 y = v[j] * rstd * gg + bb;
            xo[64 * j] = y;
            o8[64 * j] = (unsigned long long)pk2(y.x, y.y) | ((unsigned long long)pk2(y.z, y.w) << 32);
        }
    }
}

__device__ __forceinline__ void conv_gate_phase(Frame& F, const bf16* U, const float* cw, const float* cb, bf16* Hh, int row0, int nrows) {
    const int NCH = FF / 8;
    const long total = (long)nrows * NCH;
    for (long it = (long)blockIdx.x * (NWAVES * 64) + F.tid; it < total; it += (long)F.G * NWAVES * 64) {
        const int lr = (int)(it / NCH), c8 = (int)(it % NCH), c = c8 * 8;
        const int s = (row0 + lr) % SEQ;
        const int ug = 256 * (c >> 7) + (c & 127), uv = ug + 128;
        float g[8], vv[8];
#pragma unroll
        for (int e = 0; e < 8; ++e) { g[e] = cb[c + e]; vv[e] = cb[FF + c + e]; }
#pragma unroll
        for (int j = 0; j < 3; ++j) {
            const int back = 2 - j;
            if (s >= back) {
                const bf16x8 a = *(const GAS bf16x8*)(U + (size_t)(lr - back) * FF2 + ug);
                const bf16x8 bq = *(const GAS bf16x8*)(U + (size_t)(lr - back) * FF2 + uv);
#pragma unroll
                for (int e = 0; e < 8; ++e) { g[e] += cw[j * FF2 + c + e] * bf2f((unsigned short)a[e]); vv[e] += cw[j * FF2 + FF + c + e] * bf2f((unsigned short)bq[e]); }
            }
        }
        v4u o; float r[8];
#pragma unroll
        for (int e = 0; e < 8; ++e) r[e] = g[e] / (1.f + expf(-g[e])) * vv[e];
        o.x = pk2(r[0], r[1]); o.y = pk2(r[2], r[3]); o.z = pk2(r[4], r[5]); o.w = pk2(r[6], r[7]);
        *(GAS v4u*)(Hh + (size_t)lr * FF + c) = o;
    }
}

__device__ __forceinline__ void rope_phase(Frame& F, bf16* Q1, bf16* K12, const float* cosT, const float* sinT) {
    const long total = (long)M * 256;
    for (long it = (long)blockIdx.x * (NWAVES * 64) + F.tid; it < total; it += (long)F.G * NWAVES * 64) {
        const int t = (int)(it >> 8), w = (int)(it & 255), ch = w & 127; bf16* buf = (w >> 7) ? K12 : Q1;
        const int a = ch & 7, s = t % SEQ;
        bf16* p = buf + (size_t)t * D + ch * 8;
        const bf16x8 v = *(const GAS bf16x8*)p;
        const f32x4 cs = *(const GAS f32x4*)(cosT + s * 32 + 4 * a), sn = *(const GAS f32x4*)(sinT + s * 32 + 4 * a);
        float o[8];
#pragma unroll
        for (int e = 0; e < 4; ++e) { const float t1 = bf2f((unsigned short)v[e]), t2 = bf2f((unsigned short)v[4 + e]); o[e] = t1 * cs[e] - t2 * sn[e]; o[4 + e] = t2 * cs[e] + t1 * sn[e]; }
        v4u ov; ov.x = pk2(o[0], o[1]); ov.y = pk2(o[2], o[3]); ov.z = pk2(o[4], o[5]); ov.w = pk2(o[6], o[7]);
        *(GAS v4u*)p = ov;
    }
}

__device__ __forceinline__ void attn_fox_simple(Frame& F, const bf16* Q, const bf16* K, const bf16* V, bf16* O, const double* ck) {
    LAS float* Ks = (LAS float*)(F.lds + RING_OFF);
    LAS float* Vs = (LAS float*)(F.lds + RING_OFF + 16384);
    LAS double* cks = (LAS double*)(F.lds + RING_OFF + 32768);
    const int bh = (int)blockIdx.x >> 2, jj = (int)blockIdx.x & 3, b = bh >> 4, h = bh & 15;
    for (int ui = 0; ui < 2; ++ui) {
        const int rb = ui == 0 ? jj : 7 - jj, q0 = rb * 512, row = q0 + F.tid;
        const size_t t = (size_t)b * SEQ + row;
        float q[64];
#pragma unroll
        for (int c = 0; c < 8; ++c) { const bf16x8 v = *(const GAS bf16x8*)(Q + t * D + h * 64 + c * 8);
#pragma unroll
            for (int e = 0; e < 8; ++e) q[c * 8 + e] = bf2f((unsigned short)v[e]); }
        const double cq = ck[(size_t)bh * SEQ + row];
        float o[64];
#pragma unroll
        for (int d = 0; d < 64; ++d) o[d] = 0.f;
        float mrun = -INFINITY, l = 0.f;
        const int nkt = (q0 + 512) / 64;
        for (int kt = 0; kt < nkt; ++kt) {
            __syncthreads();
            { const int r = F.tid >> 3, c = F.tid & 7; const size_t kr = ((size_t)b * SEQ + kt * 64 + r) * D + h * 64 + c * 8;
              const bf16x8 kv = *(const GAS bf16x8*)(K + kr); const bf16x8 vv = *(const GAS bf16x8*)(V + kr);
#pragma unroll
              for (int e = 0; e < 8; ++e) { Ks[r * 64 + c * 8 + e] = bf2f((unsigned short)kv[e]); Vs[r * 64 + c * 8 + e] = bf2f((unsigned short)vv[e]); }
              if (F.tid < 64) cks[F.tid] = ck[(size_t)bh * SEQ + kt * 64 + F.tid]; }
            __syncthreads();
            if (kt * 64 <= row) {
                for (int j = 0; j < 64; ++j) {
                    float s = 0.f;
#pragma unroll
                    for (int d = 0; d < 64; d += 4) { const f32x4 kk = *(const LAS f32x4*)(Ks + j * 64 + d); s += (q[d] * kk.x + q[d + 1] * kk.y) + (q[d + 2] * kk.z + q[d + 3] * kk.w); }
                    s += (float)(cq - cks[j]);
                    if (kt * 64 + j > row) s = -INFINITY;
                    if (s > mrun) { const float sc = exp2f(mrun - s); l *= sc;
#pragma unroll
                        for (int d = 0; d < 64; ++d) o[d] *= sc;
                        mrun = s; }
                    const float p = exp2f(s - mrun); l += p;
#pragma unroll
                    for (int d = 0; d < 64; d += 4) { const f32x4 vv = *(const LAS f32x4*)(Vs + j * 64 + d); o[d] += p * vv.x; o[d + 1] += p * vv.y; o[d + 2] += p * vv.z; o[d + 3] += p * vv.w; }
                }
            }
        }
        const float inv = 1.f / l;
#pragma unroll
        for (int c = 0; c < 8; ++c) { v4u w; w.x = pk2(o[c * 8] * inv, o[c * 8 + 1] * inv); w.y = pk2(o[c * 8 + 2] * inv, o[c * 8 + 3] * inv); w.z = pk2(o[c * 8 + 4] * inv, o[c * 8 + 5] * inv); w.w = pk2(o[c * 8 + 6] * inv, o[c * 8 + 7] * inv);
            *(GAS v4u*)(O + t * D + h * 64 + c * 8) = w; }
    }
    __syncthreads();
}
__device__ __forceinline__ void attn_diff_simple(Frame& F, const bf16* Q1, const bf16* K12, const bf16* V, bf16* O, float* S1, const float* lamp, const float* subg) {
    LAS float* Ks = (LAS float*)(F.lds + RING_OFF);
    LAS float* Vs = (LAS float*)(F.lds + RING_OFF + 16384);
    float s01 = 0.f, s23 = 0.f;
    for (int e = 0; e < 64; ++e) { s01 += lamp[e] * lamp[64 + e]; s23 += lamp[128 + e] * lamp[192 + e]; }
    const float lam = expf(s01) - expf(s23) + LAMBDA_INIT;
    const int bh = (int)blockIdx.x >> 3, jj = (int)blockIdx.x & 7, b = bh >> 3, h = bh & 7;
    const int half = F.tid & 1;
    for (int ui = 0; ui < 2; ++ui) {
        const int rb = ui == 0 ? jj : 15 - jj, q0 = rb * 256, row = q0 + (F.tid >> 1);
        const size_t t = (size_t)b * SEQ + row;
        const int nkt = (q0 + 256) / 64;
        for (int i = 0; i < 2; ++i) {
            float q[64];
#pragma unroll
            for (int c = 0; c < 8; ++c) { const bf16x8 v = *(const GAS bf16x8*)(Q1 + t * D + i * 512 + h * 64 + c * 8);
#pragma unroll
                for (int e = 0; e < 8; ++e) q[c * 8 + e] = bf2f((unsigned short)v[e]); }
            float o[64];
#pragma unroll
            for (int d = 0; d < 64; ++d) o[d] = 0.f;
            float mrun = -INFINITY, l = 0.f;
            for (int kt = 0; kt < nkt; ++kt) {
                __syncthreads();
                { const int r = F.tid >> 3, c = F.tid & 7; const size_t rowk = (size_t)b * SEQ + kt * 64 + r;
                  const bf16x8 kv = *(const GAS bf16x8*)(K12 + rowk * D + i * 512 + h * 64 + c * 8);
                  const bf16x8 v0 = *(const GAS bf16x8*)(V + rowk * D + h * 128 + c * 16); const bf16x8 v1 = *(const GAS bf16x8*)(V + rowk * D + h * 128 + c * 16 + 8);
#pragma unroll
                  for (int e = 0; e < 8; ++e) { Ks[r * 64 + c * 8 + e] = bf2f((unsigned short)kv[e]); Vs[r * 128 + c * 16 + e] = bf2f((unsigned short)v0[e]); Vs[r * 128 + c * 16 + 8 + e] = bf2f((unsigned short)v1[e]); } }
                __syncthreads();
                if (kt <= (row >> 6)) {
                    for (int j = 0; j < 64; ++j) {
                        float s = 0.f;
#pragma unroll
                        for (int d = 0; d < 64; d += 4) { const f32x4 kk = *(const LAS f32x4*)(Ks + j * 64 + d); s += (q[d] * kk.x + q[d + 1] * kk.y) + (q[d + 2] * kk.z + q[d + 3] * kk.w); }
                        if (s > mrun) { const float sc = exp2f(mrun - s); l *= sc;
#pragma unroll
                            for (int d = 0; d < 64; ++d) o[d] *= sc;
                            mrun = s; }
                        const float p = exp2f(s - mrun); l += p;
#pragma unroll
                        for (int d = 0; d < 64; d += 4) { const f32x4 vv = *(const LAS f32x4*)(Vs + j * 128 + half * 64 + d); o[d] += p * vv.x; o[d + 1] += p * vv.y; o[d + 2] += p * vv.z; o[d + 3] += p * vv.w; }
                    }
                }
            }
            const float inv = 1.f / l;
            float* sp = S1 + t * D + h * 128 + half * 64;
            if (i == 0) {
#pragma unroll
                for (int d = 0; d < 64; d += 4) *(GAS f32x4*)(sp + d) = (f32x4){o[d] * inv, o[d + 1] * inv, o[d + 2] * inv, o[d + 3] * inv};
            } else {
                float ss = 0.f;
#pragma unroll
                for (int d = 0; d < 64; d += 4) { const f32x4 a = *(const GAS f32x4*)(sp + d);
                    o[d] = a.x - lam * (o[d] * inv); o[d + 1] = a.y - lam * (o[d + 1] * inv); o[d + 2] = a.z - lam * (o[d + 2] * inv); o[d + 3] = a.w - lam * (o[d + 3] * inv);
                    ss += (o[d] * o[d] + o[d + 1] * o[d + 1]) + (o[d + 2] * o[d + 2] + o[d + 3] * o[d + 3]); }
                ss += __shfl_xor(ss, 1);
                const float rr = 1.f / sqrtf(ss * (1.f / 128.f) + RMS_EPS) * (1.f - LAMBDA_INIT);
#pragma unroll
                for (int c = 0; c < 8; ++c) { float y[8];
#pragma unroll
                    for (int e = 0; e < 8; ++e) y[e] = o[c * 8 + e] * rr * subg[half * 64 + c * 8 + e];
                    v4u w; w.x = pk2(y[0], y[1]); w.y = pk2(y[2], y[3]); w.z = pk2(y[4], y[5]); w.w = pk2(y[6], y[7]);
                    *(GAS v4u*)(O + t * D + h * 128 + half * 64 + c * 8) = w; }
            }
        }
    }
    __syncthreads();
}

__device__ __forceinline__ void rms_phase(Frame& F, const float* S, const float* subg, bf16* Ob) {
    const int gw = F.vcu * NWAVES + F.wave, NGW = F.G * NWAVES;
    const f32x4 gg = *((const GAS f32x4*)subg + (F.lane & 31));
    for (int m = gw; m < M; m += NGW) {
        const GAS f32x4* sr = (const GAS f32x4*)(S + (size_t)m * D) + F.lane;
        GAS unsigned long long* o8 = (GAS unsigned long long*)(Ob + (size_t)m * D) + F.lane;
#pragma unroll
        for (int j = 0; j < 4; ++j) {
            const f32x4 v = sr[64 * j];
            float ss = (v.x * v.x + v.y * v.y) + (v.z * v.z + v.w * v.w);
#pragma unroll
            for (int o = 1; o < 32; o <<= 1) ss += __shfl_xor(ss, o);
            const float rr = 1.f / sqrtf(ss * (1.f / 128.f) + RMS_EPS) * (1.f - LAMBDA_INIT);
            const f32x4 y = v * rr * gg;
            o8[64 * j] = (unsigned long long)pk2(y.x, y.y) | ((unsigned long long)pk2(y.z, y.w) << 32);
        }
    }
}

enum Phase { PH_PRO = 0, PH_QKV0, PH_ATT0, PH_WO0, PH_LNA0,
             PH_UP0A, PH_CV0A, PH_DN0A, PH_LNF0A, PH_UP0B, PH_CV0B, PH_DN0B, PH_LNF0B,
             PH_QKV1, PH_ROPE1, PH_ATT1, PH_WO1, PH_LNA1,
             PH_UP1A, PH_CV1A, PH_DN1A, PH_LNF1A, PH_UP1B, PH_CV1B, PH_DN1B, PH_LNF1B, PH_COUNT };

#define EN(b) ((PHMASK >> (b)) & 1u)
template <unsigned PHMASK> __global__ void __launch_bounds__(NWAVES * 64, 2) yoco_fwd(Args args) {
    extern __shared__ __attribute__((aligned(16))) unsigned char lds[];
    Frame F;
    F.lds = (LAS unsigned char*)lds;
    F.MISC = (volatile LAS unsigned*)(F.lds + MISC_OFF);
    F.tid = threadIdx.x; F.lane = F.tid & 63; F.wave = __builtin_amdgcn_readfirstlane(F.tid >> 6);
    F.G = gridDim.x; { const int bx = blockIdx.x; F.vcu = (F.G % 8 == 0) ? (bx % 8) * (F.G / 8) + bx / 8 : bx; }
    unsigned char* ws = args.ws;
    F.ctl = (gu32*)(ws + WS_CTL);
    for (int u = F.tid; u < (LDS_BYTES - LDSCTL_OFF) / 4; u += NWAVES * 64) ((LAS unsigned*)(F.lds + LDSCTL_OFF))[u] = 0u;
    __syncthreads();
    XcdBarrier bar; bar.bar = (unsigned*)(F.ctl + CW_BAR); bar.x = 0; bar.st = nullptr;
    const bool multi = (args.ph_hi - args.ph_lo) > 1;
    if (multi) bar = xcd_barrier_post((unsigned*)(F.ctl + CW_BAR), F.MISC + 8);

    if (EN(2) && args.ph_lo == PH_PRO) p0_prologue(F, args);
    for (int ph = args.ph_lo; ph < args.ph_hi; ++ph) {
        { int t_ = threadIdx.x; asm volatile("" : "+v"(t_)); F.tid = t_; F.lane = t_ & 63; F.wave = __builtin_amdgcn_readfirstlane(t_ >> 6); }
        bf16* XB = (bf16*)(ws + WS_XB); bf16* QO = (bf16*)(ws + WS_QO); bf16* KB = (bf16*)(ws + WS_KB); bf16* VB = (bf16*)(ws + WS_VB);
        float* HS = (float*)(ws + WS_HS); bf16* UH = (bf16*)(ws + WS_UH); bf16* HH = (bf16*)(ws + WS_HH); float* HSH = (float*)(ws + WS_HSH);
        const float* cosT = (const float*)(ws + WS_COS); const float* sinT = (const float*)(ws + WS_SIN);

        int kind = 0; pg8::Gemm g{nullptr, nullptr, 0, 0, 0};
        bf16* ob = nullptr; int ob_ld = 0, ob_split = 0; size_t ob_stride = 0; float ob_scale = 1.f; float* of = nullptr;
        const int layer = ph >= PH_QKV1 ? 1 : 0;
        const bf16* WIN = (const bf16*)(ws + (layer ? WS_WIN1 : WS_WIN0)); const bf16* WOUT = (const bf16*)(ws + (layer ? WS_WOUT1 : WS_WOUT0));
        int half = 0;
        switch (ph) {
            case PH_QKV0: kind = 1; g = pg8::Gemm{XB, (const bf16*)(ws + WS_WQKV0), M, 3 * D, D}; ob = QO; ob_ld = D; ob_split = D; ob_stride = (WS_KB - WS_QO) / 2; ob_scale = C2; break;
            case PH_QKV1: kind = 1; g = pg8::Gemm{XB, (const bf16*)(ws + WS_WQKV1), M, 3 * D, D}; ob = QO; ob_ld = D; ob_split = D; ob_stride = (WS_KB - WS_QO) / 2; ob_scale = C2; break;
            case PH_WO0: kind = 2; g = pg8::Gemm{QO, (const bf16*)(ws + WS_WO0), M, D, D}; of = HS; break;
            case PH_WO1: kind = 2; g = pg8::Gemm{XB, (const bf16*)(ws + WS_WO1), M, D, D}; of = HS; break;
            case PH_UP0B: case PH_UP1B: half = 1; [[fallthrough]];
            case PH_UP0A: case PH_UP1A: kind = 1; g = pg8::Gemm{XB + (size_t)half * (M / 2) * D, WIN, M / 2, FF2, D}; ob = UH; ob_ld = FF2; break;
            case PH_DN0B: case PH_DN1B: half = 1; [[fallthrough]];
            case PH_DN0A: case PH_DN1A: kind = 2; g = pg8::Gemm{HH, WOUT, M / 2, D, FF}; of = HSH; break;
            case PH_CV0B: case PH_CV1B: case PH_LNF0B: case PH_LNF1B: half = 1; break;
            default: break;
        }
        if (EN(0) && kind == 1) {
            pg8::StaticOrder S; S.init(g.M, g.N, F.G, (int)blockIdx.x);
            pg8::EpiBf16<0> E{ob, ob_ld, nullptr, ob_split, ob_stride, ob_scale};
            if (ph == PH_QKV0) scan_phase(F, args);
            pg8::gemm_phase<pg8::EpiBf16<0>, pg8::StaticOrder, PG8_ALIGN, PG8_SP2>(F.lds + RING_OFF, g, S, E);
        } else if (EN(1) && kind == 2) {
            pg8::StaticOrder S; S.init(g.M, g.N, F.G, (int)blockIdx.x);
            pg8::EpiF32 E{of, D};
            pg8::gemm_phase<pg8::EpiF32, pg8::StaticOrder, PG8_ALIGN, PG8_SP2>(F.lds + RING_OFF, g, S, E);
        } else if (EN(3) && ph == PH_ATT0) {
            const attn_body::AttnTensors AT{(const attn_body::bf16*)QO, (const attn_body::bf16*)KB, (const attn_body::bf16*)VB, (attn_body::bf16*)QO};
            const attn_body::StaticOrder S((int)F.G, (int)blockIdx.x);
            attn_body::attn_phase<attn_body::StaticOrder, 8, true>((char*)lds + RING_OFF, AT, S, ws + WS_BT);
        } else if (EN(4) && ph == PH_ATT1) {
            const float* lamp = args.in[6]; float s01 = 0.f, s23 = 0.f;
            for (int e = 0; e < 64; ++e) { s01 += lamp[e] * lamp[64 + e]; s23 += lamp[128 + e] * lamp[192 + e]; }
            const float lam = expf(s01) - expf(s23) + LAMBDA_INIT;
            attn_body::diff_phase<8>((char*)lds + RING_OFF, (const attn_body::bf16*)QO, (const attn_body::bf16*)KB, (const attn_body::bf16*)VB, HS, lam, (int)F.G, (int)blockIdx.x);
            xcd_barrier(bar);
            rms_phase(F, HS, args.in[7], XB);
        } else if (EN(5) && ph == PH_ROPE1) {
            rope_phase(F, QO, KB, cosT, sinT);
        } else if (EN(6) && ph == PH_LNA0) {
            ln_phase(F, args.in[0], HS, args.in[13], args.in[14], args.out, XB, 0, M);
        } else if (EN(6) && ph == PH_LNA1) {
            ln_phase(F, args.out, HS, args.in[13] + D, args.in[14] + D, args.out, XB, 0, M);
        } else if (EN(7) && (ph == PH_CV0A || ph == PH_CV0B || ph == PH_CV1A || ph == PH_CV1B)) {
            conv_gate_phase(F, UH, args.in[10] + (size_t)layer * 3 * FF2, args.in[11] + (size_t)layer * FF2, HH, half * (M / 2), M / 2);
        } else if (EN(6) && (ph == PH_LNF0A || ph == PH_LNF0B || ph == PH_LNF1A || ph == PH_LNF1B)) {
            ln_phase(F, args.out, HSH, args.in[15] + (size_t)layer * D, args.in[16] + (size_t)layer * D, args.out, XB, half * (M / 2), M / 2);
        }
        if (ph + 1 < args.ph_hi) xcd_barrier(bar);
    }
}

#ifndef ONE_LAUNCH
#define ONE_LAUNCH 1
#endif
static unsigned phase_mask(int ph) {
    switch (ph) {
        case PH_QKV0: case PH_QKV1: case PH_UP0A: case PH_UP0B: case PH_UP1A: case PH_UP1B: return 0x1u;
        case PH_WO0: case PH_WO1: case PH_DN0A: case PH_DN0B: case PH_DN1A: case PH_DN1B: return 0x2u;
        case PH_PRO: return 0x4u;
        case PH_ATT0: return 0x8u;
        case PH_ATT1: return 0x10u;
        default: return 0xE0u;
    }
}
template <unsigned MASK> static void launch_one(int grid, const Args& a, hipStream_t stream) {
    static bool attr_done = false;
    if (!attr_done) { (void)hipFuncSetAttribute((const void*)yoco_fwd<MASK>, hipFuncAttributeMaxDynamicSharedMemorySize, LDS_BYTES); attr_done = true; }
    hipLaunchKernelGGL(yoco_fwd<MASK>, dim3(grid), dim3(NWAVES * 64), LDS_BYTES, stream, a);
}
extern "C" void kernel_launch(void* const* d_in, const int* in_sizes, int n_in, void* d_out, int out_size, void* d_ws, size_t ws_size, hipStream_t stream) {
    static int grid = 0;
    if (grid == 0) {
        if (n_in != 17 || out_size != M * D || ws_size < WS_END) { fprintf(stderr, "kernel_launch: unexpected shapes (n_in %d out %d ws %zu)\n", n_in, out_size, ws_size); grid = -1; return; }
        int dev = 0, cus = 0;
        if (hipGetDevice(&dev) != hipSuccess || hipDeviceGetAttribute(&cus, hipDeviceAttributeMultiprocessorCount, dev) != hipSuccess) { grid = -1; return; }
        (void)hipGetLastError();
        grid = cus;
        if (grid != 256) fprintf(stderr, "kernel_launch: %d CUs; this build expects 256\n", grid);
    }
    if (grid < 0) return;
    (void)hipMemsetAsync((char*)d_ws + WS_CTL, 0, CTL_ZERO_BYTES, stream);
    Args a{};
    for (int i = 0; i < 17; ++i) a.in[i] = (const float*)d_in[i];
    a.out = (float*)d_out; a.ws = (unsigned char*)d_ws;
#if ONE_LAUNCH
    a.ph_lo = 0; a.ph_hi = PH_COUNT; launch_one<0xFFu>(grid, a, stream);
#else
    for (int ph = 0; ph < PH_COUNT; ++ph) {
        a.ph_lo = ph; a.ph_hi = ph + 1;
        switch (phase_mask(ph)) {
            case 0x1u: launch_one<0x1u>(grid, a, stream); break;
            case 0x2u: launch_one<0x2u>(grid, a, stream); break;
            case 0x4u: launch_one<0x4u>(grid, a, stream); break;
            case 0x8u: launch_one<0x8u>(grid, a, stream); break;
            case 0x10u: launch_one<0x10u>(grid, a, stream); break;
            default: launch_one<0xE0u>(grid, a, stream); break;
        }
    }
#endif
}
```

```cpp
#include <hip/hip_runtime.h>
#include <hip/hip_bf16.h>
#include <cstdio>
#include <cstdint>
#include <cmath>
namespace pg8 {
#define PG8_LAS __attribute__((address_space(3)))
typedef unsigned short bf16_t;
typedef short bf16x8 __attribute__((ext_vector_type(8)));
typedef float f32x4 __attribute__((ext_vector_type(4)));
typedef unsigned u32x4 __attribute__((ext_vector_type(4)));
constexpr int BM = 256, BK = 64, HALF = 128, HTB = HALF * BK * 2  , STAGE_BYTES = 8 * HTB, NXCD = 8, WGM = 8;

__host__ __device__ __forceinline__ int lds_byte(int r, int c) { const int st = (r >> 4) * 2 + (c >> 5), rr = r & 15, cc = c & 31, ob = rr * 64 + cc * 2; return st * 1024 + (ob ^ (((ob >> 9) & 1) << 5)); }
__host__ __device__ __forceinline__ void stage_rc(int b, int& R, int& C) { const int st = b / 1024, sb = b % 1024, swz = sb ^ (((sb >> 9) & 1) << 5); R = (st >> 1) * 16 + swz / 64; C = (st & 1) * 32 + (swz % 64) / 2; }
__host__ __device__ __forceinline__ int perm32(int rho) { const int n = rho >> 4, i = rho & 15; return 8 * (i >> 2) + 4 * n + (i & 3); }

struct Unit { int pm, pn; };
struct Gemm { const bf16_t* A; const bf16_t* Bt; int M, N, K; };

struct StaticOrder {
    int nM, nN, nwg, G, c;
    __host__ __device__ void init(int M, int N, int G_, int c_) { nM = M / BM; nN = N / BM; nwg = nM * nN; G = G_; c = c_; }
    __host__ __device__ bool next(int i, Unit& u) const {
        const long L = (long)i * G + c; if (L >= nwg) return false;
        int wgid = (int)L; { const int q = nwg / NXCD, r = nwg % NXCD, xcd = wgid % NXCD, off = wgid / NXCD; wgid = (xcd < r ? xcd * (q + 1) : r * (q + 1) + (xcd - r) * q) + off; }
        const int nig = WGM * nN, gid = wgid / nig, fm = gid * WGM, gsz = (nM - fm) < WGM ? (nM - fm) : WGM;
        u.pm = fm + ((wgid % nig) % gsz); u.pn = (wgid % nig) / gsz; return true;
    }
    __device__ __forceinline__ void a_ready(const Unit&) const {}
    __device__ __forceinline__ void done(const Unit&) const {}
};

__device__ __forceinline__ unsigned cvt_pk_bf16(float lo, float hi) { unsigned r; asm volatile("v_cvt_pk_bf16_f32 %0, %1, %2" : "=v"(r) : "v"(lo), "v"(hi)); return r; }
typedef float f32x2 __attribute__((ext_vector_type(2)));
__device__ __forceinline__ f32x2 gelu_pk(f32x2 v) {
    const f32x2 av = __builtin_elementwise_abs(v), d = av * 0.2316418882f + 1.0f;
    f32x2 t; t.x = __builtin_amdgcn_rcpf(d.x); t.y = __builtin_amdgcn_rcpf(d.y);
    f32x2 q = t * 0.5307027145f + (-0.7265760135f); q = q * t + 0.7107068705f; q = q * t + (-0.142248368f); q = q * t + 0.127414796f; q = q * t;
    const f32x2 s = (v * v) * (-0.72134752044f);
    f32x2 e; e.x = __builtin_amdgcn_exp2f(s.x); e.y = __builtin_amdgcn_exp2f(s.y);
    const f32x2 m = v * (q * e), r = v - m;
    f32x2 o; o.x = v.x < 0.f ? m.x : r.x; o.y = v.y < 0.f ? m.y : r.y; return o;
}

template <int ACT  > struct EpiBf16 {
    static constexpr bool PERM = true, AFTER_DRAIN = false; static_assert(ACT == 0 || ACT == 1, "EpiBf16: ACT is 0 (none) or 1 (gelu_pk)");
    static __device__ __forceinline__ int arow(int pm) { return pm * BM; }
    bf16_t* O; int ldc; const float* bias; int split_cols; size_t split_stride; float scale0;
    __device__ __forceinline__ void operator()(const f32x4 (&acc)[2][2][4][2], const Unit& u, int wr, int wc, int fr, int fq) const {
        const int row0 = u.pm * BM + wr * 64 + fr; int colt = u.pn * BM; bf16_t* base = O;
        float sc = 1.f; if (split_cols) { const int t = colt / split_cols; base += (size_t)t * split_stride; colt -= t * split_cols; if (t == 0) sc = scale0; }
        const int col0 = colt + wc * 32 + 8 * fq, bcol0 = u.pn * BM + wc * 32 + 8 * fq;
        f32x4 bv[2][2];
#pragma unroll
        for (int bj = 0; bj < 2; ++bj)
#pragma unroll
            for (int n = 0; n < 2; ++n) bv[bj][n] = bias ? *(const f32x4*)(bias + bcol0 + bj * HALF + 4 * n) : (f32x4){0.f, 0.f, 0.f, 0.f};
#pragma unroll
        for (int ai = 0; ai < 2; ++ai)
#pragma unroll
            for (int m = 0; m < 4; ++m) { bf16_t* rowp = base + (size_t)(row0 + ai * HALF + m * 16) * ldc + col0;
#pragma unroll
                for (int bj = 0; bj < 2; ++bj) { f32x4 v0 = acc[ai][bj][m][0] + bv[bj][0], v1 = acc[ai][bj][m][1] + bv[bj][1];
                    if (ACT == 1) { f32x2 a = gelu_pk((f32x2){v0[0], v0[1]}), b = gelu_pk((f32x2){v0[2], v0[3]}), c = gelu_pk((f32x2){v1[0], v1[1]}), d = gelu_pk((f32x2){v1[2], v1[3]});
                        v0 = (f32x4){a.x, a.y, b.x, b.y}; v1 = (f32x4){c.x, c.y, d.x, d.y}; }
                    v0 = v0 * sc; v1 = v1 * sc; u32x4 w; w.x = cvt_pk_bf16(v0[0], v0[1]); w.y = cvt_pk_bf16(v0[2], v0[3]); w.z = cvt_pk_bf16(v1[0], v1[1]); w.w = cvt_pk_bf16(v1[2], v1[3]);
                    *(u32x4*)(rowp + bj * HALF) = w; } }
    }
};

struct PanelStats {
    unsigned* xbuf;
    unsigned* cnt;
    unsigned* tmo;
    int ntn; float eps;
    unsigned code;
    __device__ __forceinline__ bool run(const f32x4 (&v)[2][2][4][2], const Unit& u, int wr, int wc, int fr, int fq, PG8_LAS unsigned char* lds, int wid, int lane) const {
        typedef float f32x2v __attribute__((ext_vector_type(2)));
        PG8_LAS f32x2v* P = (PG8_LAS f32x2v*)lds;
        PG8_LAS f32x2v* S = (PG8_LAS f32x2v*)(lds + 8192);
        PG8_LAS unsigned* flag = (PG8_LAS unsigned*)(lds + 8192 + 2048);
#pragma unroll
        for (int ai = 0; ai < 2; ++ai)
#pragma unroll
            for (int m = 0; m < 4; ++m) {
                float s = 0.f;
#pragma unroll
                for (int bj = 0; bj < 2; ++bj)
#pragma unroll
                    for (int n = 0; n < 2; ++n) { const f32x4 x = v[ai][bj][m][n]; s += (x[0] + x[1]) + (x[2] + x[3]); }
                s += __shfl_xor(s, 16); s += __shfl_xor(s, 32);
                const float mw = s * (1.0f / 64.0f); float q = 0.f;
#pragma unroll
                for (int bj = 0; bj < 2; ++bj)
#pragma unroll
                    for (int n = 0; n < 2; ++n) { const f32x4 d = v[ai][bj][m][n] - mw; q += (d[0] * d[0] + d[1] * d[1]) + (d[2] * d[2] + d[3] * d[3]); }
                q += __shfl_xor(q, 16); q += __shfl_xor(q, 32);
                if (fq == 0) P[(ai * HALF + wr * 64 + m * 16 + fr) * 4 + wc] = (f32x2v){mw, q};
            }
        asm volatile("s_waitcnt lgkmcnt(0)" ::: "memory"); __builtin_amdgcn_s_barrier(); asm volatile("" ::: "memory");
#if defined(BROKEN_EXCHANGE_NO_WAIT)
#warning BROKEN CONTROL BUILD: the row-statistics exchange does not wait; results are wrong by design
        if (blockIdx.x >= 64) { const long long t0_ = clock64(); while (clock64() - t0_ < 60000) __builtin_amdgcn_s_sleep(8); }
#endif
        const int row = wid * 32 + (lane & 31);
        if (lane < 32) {
            const f32x2v a = P[row * 4 + 0], b = P[row * 4 + 1], c = P[row * 4 + 2], d = P[row * 4 + 3];
            const float mt = (a.x + b.x + c.x + d.x) * 0.25f;
            const float da = a.x - mt, db = b.x - mt, dc = c.x - mt, dd = d.x - mt;
            const float m2 = (a.y + b.y) + (c.y + d.y) + 64.0f * ((da * da + db * db) + (dc * dc + dd * dd));
            unsigned long long* slot = (unsigned long long*)xbuf + ((size_t)(u.pm * BM + row) * 4 + u.pn);
            __hip_atomic_store(slot, ((unsigned long long)__float_as_uint(m2) << 32) | __float_as_uint(mt), __ATOMIC_RELAXED, __HIP_MEMORY_SCOPE_AGENT);
        }
        asm volatile("s_waitcnt vmcnt(0)" ::: "memory");
        if (lane == 0) __hip_atomic_fetch_add(cnt + 64 * u.pm, 1u, __ATOMIC_RELAXED, __HIP_MEMORY_SCOPE_AGENT);
        if (wid == 0) {
            bool dead = false; const unsigned long long t0 = __builtin_amdgcn_s_memrealtime(); const unsigned want = 8u * (unsigned)ntn;
            for (;;) {
#if defined(BROKEN_EXCHANGE_NO_WAIT)
                break;
#endif
                if ((unsigned)__builtin_amdgcn_readfirstlane(__hip_atomic_load(cnt + 64 * u.pm, __ATOMIC_RELAXED, __HIP_MEMORY_SCOPE_AGENT)) >= want) break;
                if (__builtin_amdgcn_s_memrealtime() - t0 > 2000000ull) {
                    if (lane == 0) { unsigned expect = 0u; __hip_atomic_compare_exchange_strong(tmo + 1, &expect, code | (unsigned)(u.pm & 0xff), __ATOMIC_RELAXED, __ATOMIC_RELAXED, __HIP_MEMORY_SCOPE_AGENT);
                                     __hip_atomic_store(tmo, 1u, __ATOMIC_RELAXED, __HIP_MEMORY_SCOPE_AGENT); }
                    dead = true; break; }
                __builtin_amdgcn_s_sleep(2);
            }
            __builtin_amdgcn_fence(__ATOMIC_ACQUIRE, "agent");
            if (lane == 0) flag[0] = dead ? 1u : 0u;
        }
        asm volatile("s_waitcnt vmcnt(0) lgkmcnt(0)" ::: "memory"); __builtin_amdgcn_s_barrier(); asm volatile("" ::: "memory");
        const bool bad = flag[0] != 0u;
        if (lane < 32) {
            const unsigned long long* slot = (const unsigned long long*)xbuf + (size_t)(u.pm * BM + row) * 4; float mt[4], m2[4]; float ms = 0.f;
#pragma unroll
            for (int t = 0; t < 4; ++t) { if (t < ntn) { const unsigned long long w = __hip_atomic_load(slot + t, __ATOMIC_RELAXED, __HIP_MEMORY_SCOPE_AGENT); mt[t] = __uint_as_float((unsigned)w); m2[t] = __uint_as_float((unsigned)(w >> 32)); } else { mt[t] = 0.f; m2[t] = 0.f; } ms += mt[t]; }
            const float mean = ms / (float)ntn; float q = 0.f;
#pragma unroll
            for (int t = 0; t < 4; ++t) if (t < ntn) { const float dm = mt[t] - mean; q += m2[t] + 256.0f * dm * dm; }
            S[row] = (f32x2v){mean, 1.0f / sqrtf(q / (256.0f * (float)ntn) + eps)};
        }
        asm volatile("s_waitcnt lgkmcnt(0)" ::: "memory"); __builtin_amdgcn_s_barrier(); asm volatile("" ::: "memory");
        return bad;
    }
};
struct EpiLnRes {
    static constexpr bool PERM = false, AFTER_DRAIN = true;
    static __device__ __forceinline__ int arow(int pm) { return pm * BM; }
    const float* base; float* out; int ldc; const float* bias; PanelStats st; unsigned poison;
    __device__ __forceinline__ void fused(f32x4 (&acc)[2][2][4][2], const Unit& u, int wr, int wc, int fr, int fq, PG8_LAS unsigned char* lds, int wid, int lane) const {
        typedef float f32x2v __attribute__((ext_vector_type(2)));
        const PG8_LAS f32x2v* S = (const PG8_LAS f32x2v*)(lds + 8192);
        const int col0 = u.pn * BM + wc * 32 + 4 * fq;
#pragma unroll
        for (int bj = 0; bj < 2; ++bj)
#pragma unroll
            for (int n = 0; n < 2; ++n) { const f32x4 bv = bias ? *(const f32x4*)(bias + col0 + bj * HALF + n * 16) : (f32x4){0.f, 0.f, 0.f, 0.f};
#pragma unroll
                for (int ai = 0; ai < 2; ++ai)
#pragma unroll
                    for (int m = 0; m < 4; ++m) acc[ai][bj][m][n] += bv; }
        f32x4 pre[4][2][2];
#pragma unroll
        for (int m = 0; m < 4; ++m) { const size_t off = (size_t)(u.pm * BM + wr * 64 + m * 16 + fr) * ldc + col0;
#pragma unroll
            for (int bj = 0; bj < 2; ++bj)
#pragma unroll
                for (int n = 0; n < 2; ++n) pre[m][bj][n] = *(const f32x4*)(base + off + bj * HALF + n * 16); }
        const bool bad = st.run(acc, u, wr, wc, fr, fq, lds, wid, lane) || poison != 0u;
        const float qnan = __builtin_nanf("");
#pragma unroll
        for (int ai = 0; ai < 2; ++ai)
#pragma unroll
            for (int m = 0; m < 4; ++m) { const int r = ai * HALF + wr * 64 + m * 16 + fr; const f32x2v sr = S[r]; const size_t off = (size_t)(u.pm * BM + r) * ldc + col0;
#pragma unroll
                for (int bj = 0; bj < 2; ++bj)
#pragma unroll
                    for (int n = 0; n < 2; ++n) { const f32x4 bs = ai == 0 ? pre[m][bj][n] : *(const f32x4*)(base + off + bj * HALF + n * 16); f32x4 o = bs + (acc[ai][bj][m][n] - sr.x) * sr.y;
                        if (bad) o = (f32x4){qnan, qnan, qnan, qnan}; *(f32x4*)(out + off + bj * HALF + n * 16) = o; }
                if (m & 1) asm volatile("" ::: "memory"); }
    }
};
struct EpiLnResLn {
    static constexpr bool PERM = false, AFTER_DRAIN = true;
    static __device__ __forceinline__ int arow(int pm) { return pm * BM; }
    const float* base; float* out; bf16_t* xn; int ldc; const float* bias; PanelStats st1, st2; unsigned poison;
    __device__ __forceinline__ void fused(f32x4 (&acc)[2][2][4][2], const Unit& u, int wr, int wc, int fr, int fq, PG8_LAS unsigned char* lds, int wid, int lane) const {
        typedef float f32x2v __attribute__((ext_vector_type(2))); typedef unsigned u32x2v __attribute__((ext_vector_type(2)));
        const PG8_LAS f32x2v* S = (const PG8_LAS f32x2v*)(lds + 8192);
        const int col0 = u.pn * BM + wc * 32 + 4 * fq;
#pragma unroll
        for (int bj = 0; bj < 2; ++bj)
#pragma unroll
            for (int n = 0; n < 2; ++n) { const f32x4 bv = bias ? *(const f32x4*)(bias + col0 + bj * HALF + n * 16) : (f32x4){0.f, 0.f, 0.f, 0.f};
#pragma unroll
                for (int ai = 0; ai < 2; ++ai)
#pragma unroll
                    for (int m = 0; m < 4; ++m) acc[ai][bj][m][n] += bv; }
        bool bad = st1.run(acc, u, wr, wc, fr, fq, lds, wid, lane) || poison != 0u;
        const float qnan = __builtin_nanf("");
#pragma unroll
        for (int ai = 0; ai < 2; ++ai)
#pragma unroll
            for (int m = 0; m < 4; ++m) { const int r = ai * HALF + wr * 64 + m * 16 + fr; const f32x2v sr = S[r]; const size_t off = (size_t)(u.pm * BM + r) * ldc + col0;
#pragma unroll
                for (int bj = 0; bj < 2; ++bj)
#pragma unroll
                    for (int n = 0; n < 2; ++n) { const f32x4 bs = *(const f32x4*)(base + off + bj * HALF + n * 16); acc[ai][bj][m][n] = bs + (acc[ai][bj][m][n] - sr.x) * sr.y; }
                asm volatile("" : "+v"(acc[ai][0][m][0]), "+v"(acc[ai][0][m][1]), "+v"(acc[ai][1][m][0]), "+v"(acc[ai][1][m][1]));
                if (m & 1) asm volatile("" ::: "memory"); }
        const bool bad1 = bad;
        bad = st2.run(acc, u, wr, wc, fr, fq, lds, wid, lane) || bad;
#pragma unroll
        for (int ai = 0; ai < 2; ++ai)
#pragma unroll
            for (int m = 0; m < 4; ++m) { const int r = ai * HALF + wr * 64 + m * 16 + fr; const f32x2v sr = S[r]; const size_t off = (size_t)(u.pm * BM + r) * ldc + col0;
#pragma unroll
                for (int bj = 0; bj < 2; ++bj)
#pragma unroll
                    for (int n = 0; n < 2; ++n) { const f32x4 x1 = acc[ai][bj][m][n]; *(f32x4*)(out + off + bj * HALF + n * 16) = bad1 ? (f32x4){qnan, qnan, qnan, qnan} : x1;
                        const f32x4 o = (x1 - sr.x) * sr.y; u32x2v w; w.x = cvt_pk_bf16(o[0], o[1]); w.y = cvt_pk_bf16(o[2], o[3]);
                        if (bad) { w.x = 0x7fc07fc0u; w.y = 0x7fc07fc0u; } *(u32x2v*)(xn + off + bj * HALF + n * 16) = w; }
                asm volatile("" ::: "memory"); }
    }
};

template <class Epi, class Sched, bool ALIGN_EPI = false, bool SP2 = false>
__device__ __forceinline__ void gemm_phase(PG8_LAS unsigned char* lds, const Gemm g, const Sched& S, const Epi& E) {
    int tid_ = threadIdx.x; asm volatile("" : "+v"(tid_));
    const int tid = tid_, wid = __builtin_amdgcn_readfirstlane(tid >> 6), lane = tid & 63, wr = wid >> 2, wc = wid & 3, fr = lane & 15, fq = lane >> 4;
    const int K = g.K, nt = K / BK;
    unsigned voffA[2], voffB[2];
#pragma unroll
    for (int i = 0; i < 2; ++i) { int R, C; stage_rc(tid * 16 + i * 8192, R, C); const int Rb = Epi::PERM ? ((R & ~31) + perm32(R & 31)) : R;
        voffA[i] = (unsigned)(R * K + C) * 2u; voffB[i] = (unsigned)(Rb * K + C) * 2u; }
    const size_t kstep = (size_t)(BK * 2);
    const size_t hstep = (size_t)HALF * K * 2;
    const size_t tstep = 2 * hstep;
    const unsigned ldsw = (unsigned)wid * 1024u;
    const int aoff = lds_byte(wr * 64 + fr, fq * 8), boff = lds_byte(wc * 32 + fr, fq * 8);
#define PG8_SA(b, h) (((b) * 2 + (h)) * HTB)
#define PG8_SB(b, h) ((4 + (b) * 2 + (h)) * HTB)
#define PG8_STAGE(bufoff, gbase, voff) do { _Pragma("unroll") for (int _i = 0; _i < 2; ++_i) \
        __builtin_amdgcn_global_load_lds((const unsigned*)((const char*)(gbase) + (voff)[_i]), (PG8_LAS unsigned*)(lds + (bufoff) + ldsw + _i * 8192), 16, 0, 0); } while (0)
#define PG8_LDA(dst, b, h) do { _Pragma("unroll") for (int m = 0; m < 4; ++m) _Pragma("unroll") for (int k = 0; k < 2; ++k) dst[m][k] = *(const PG8_LAS bf16x8*)(lds + PG8_SA(b, h) + aoff + m * 2048 + k * 1024); } while (0)
#define PG8_LDB(dst, b, h) do { _Pragma("unroll") for (int n = 0; n < 2; ++n) _Pragma("unroll") for (int k = 0; k < 2; ++k) dst[n][k] = *(const PG8_LAS bf16x8*)(lds + PG8_SB(b, h) + boff + n * 2048 + k * 1024); } while (0)
#define PG8_MMA(ai, bj, At, Bt) do { __builtin_amdgcn_s_setprio(1); _Pragma("unroll") for (int m = 0; m < 4; ++m) _Pragma("unroll") for (int n = 0; n < 2; ++n) _Pragma("unroll") for (int k = 0; k < 2; ++k) \
        acc[ai][bj][m][n] = __builtin_amdgcn_mfma_f32_16x16x32_bf16(Bt[n][k], At[m][k], acc[ai][bj][m][n], 0, 0, 0); __builtin_amdgcn_s_setprio(0); } while (0)
#define PG8_WAIT_V(n) asm volatile("s_waitcnt vmcnt(" #n ")" ::: "memory")
#define PG8_WAIT_L(n) asm volatile("s_waitcnt lgkmcnt(" #n ")" ::: "memory")
#define PG8_BAR __builtin_amdgcn_s_barrier()
#define PG8_SCHED __builtin_amdgcn_sched_barrier(0)
    Unit cur, nxt; int ui = 0;
    if (!S.next(0, cur)) return;
    f32x4 acc[2][2][4][2];
#pragma unroll
    for (int a = 0; a < 2; ++a)
#pragma unroll
        for (int b = 0; b < 2; ++b)
#pragma unroll
            for (int m = 0; m < 4; ++m)
#pragma unroll
                for (int n = 0; n < 2; ++n) acc[a][b][m][n] = (f32x4){0.f, 0.f, 0.f, 0.f};
    bf16x8 At[4][2], B0[2][2], B1[2][2];
    const size_t rstepA = (size_t)K * 2;
    const char* cA = (const char*)g.A + (long)Epi::arow(cur.pm) * (long)rstepA; const char* cB = (const char*)g.Bt + (size_t)cur.pn * tstep;
    S.a_ready(cur);
    if constexpr (SP2) {
        PG8_STAGE(PG8_SB(0, 0), cB, voffB); PG8_STAGE(PG8_SB(0, 1), cB + hstep, voffB); PG8_STAGE(PG8_SA(0, 0), cA, voffA); PG8_STAGE(PG8_SA(0, 1), cA + hstep, voffA);
        if (wr == 1) PG8_BAR;
        PG8_WAIT_V(2); PG8_BAR;
        PG8_STAGE(PG8_SB(1, 0), cB + kstep, voffB); PG8_STAGE(PG8_SA(1, 0), cA + kstep, voffA); PG8_STAGE(PG8_SB(1, 1), cB + hstep + kstep, voffB);
        PG8_WAIT_V(6); PG8_BAR;
    } else {
        PG8_STAGE(PG8_SB(0, 0), cB, voffB); PG8_STAGE(PG8_SA(0, 0), cA, voffA); PG8_STAGE(PG8_SB(0, 1), cB + hstep, voffB); PG8_STAGE(PG8_SA(0, 1), cA + hstep, voffA);
        if (wr == 1) PG8_BAR;
        PG8_WAIT_V(4); PG8_BAR;
        PG8_STAGE(PG8_SB(1, 0), cB + kstep, voffB); PG8_STAGE(PG8_SA(1, 0), cA + kstep, voffA); PG8_STAGE(PG8_SB(1, 1), cB + hstep + kstep, voffB);
        PG8_WAIT_V(6); PG8_BAR;
    }
    for (;;) {
        const bool has_next = S.next(ui + 1, nxt);
        const char* nA = has_next ? (const char*)g.A + (long)Epi::arow(nxt.pm) * (long)rstepA : cA; const char* nB = has_next ? (const char*)g.Bt + (size_t)nxt.pn * tstep : cB;
        for (int t = 0; t < nt; t += 2) {
            const bool last = (t == nt - 2);
            const char* a1 = cA + (size_t)(t + 1) * kstep;
            const char* a2 = last ? nA : cA + (size_t)(t + 2) * kstep; const char* b2 = last ? nB : cB + (size_t)(t + 2) * kstep;
            const char* a3 = a2 + kstep; const char* b3 = b2 + kstep;
            if (last && has_next) S.a_ready(nxt);
            if constexpr (SP2) {
            PG8_LDB(B0, 0, 0); PG8_LDB(B1, 0, 1); PG8_SCHED; PG8_LDA(At, 0, 0); PG8_STAGE(PG8_SA(1, 1), a1 + hstep, voffA);
            PG8_WAIT_V(8); PG8_WAIT_L(0); PG8_BAR; PG8_MMA(0, 0, At, B0); PG8_MMA(0, 1, At, B1); PG8_BAR; PG8_SCHED;
            PG8_LDA(At, 0, 1); PG8_STAGE(PG8_SB(0, 0), b2, voffB); PG8_STAGE(PG8_SB(0, 1), b2 + hstep, voffB); PG8_STAGE(PG8_SA(0, 0), a2, voffA);
            PG8_WAIT_V(8); PG8_WAIT_L(0); PG8_BAR; PG8_MMA(1, 0, At, B0); PG8_MMA(1, 1, At, B1); PG8_BAR; PG8_SCHED;
            PG8_LDB(B0, 1, 0); PG8_LDB(B1, 1, 1); PG8_SCHED; PG8_LDA(At, 1, 0); PG8_STAGE(PG8_SA(0, 1), a2 + hstep, voffA);
            PG8_WAIT_V(8); PG8_WAIT_L(0); PG8_BAR; PG8_MMA(0, 0, At, B0); PG8_MMA(0, 1, At, B1); PG8_BAR; PG8_SCHED;
            PG8_LDA(At, 1, 1); PG8_STAGE(PG8_SB(1, 0), b3, voffB); PG8_STAGE(PG8_SB(1, 1), b3 + hstep, voffB); PG8_STAGE(PG8_SA(1, 0), a3, voffA);
            PG8_WAIT_V(8); PG8_WAIT_L(0); PG8_BAR; PG8_MMA(1, 0, At, B0); PG8_MMA(1, 1, At, B1); PG8_BAR; PG8_SCHED;
            } else {
            PG8_LDB(B0, 0, 0); PG8_SCHED; PG8_LDA(At, 0, 0); PG8_STAGE(PG8_SA(1, 1), a1 + hstep, voffA);
            PG8_WAIT_L(8); PG8_BAR; PG8_WAIT_L(0); PG8_MMA(0, 0, At, B0); PG8_BAR; PG8_SCHED;
            PG8_LDB(B1, 0, 1); PG8_STAGE(PG8_SB(0, 0), b2, voffB);
            PG8_BAR; PG8_WAIT_L(0); PG8_MMA(0, 1, At, B1); PG8_BAR;
            PG8_LDA(At, 0, 1); PG8_STAGE(PG8_SA(0, 0), a2, voffA);
            PG8_BAR; PG8_WAIT_L(0); PG8_MMA(1, 0, At, B0); PG8_BAR; PG8_SCHED;
            PG8_STAGE(PG8_SB(0, 1), b2 + hstep, voffB);
            PG8_WAIT_V(6); PG8_BAR; PG8_MMA(1, 1, At, B1); PG8_BAR;
            PG8_LDB(B0, 1, 0); PG8_SCHED; PG8_LDA(At, 1, 0); PG8_STAGE(PG8_SA(0, 1), a2 + hstep, voffA);
            PG8_WAIT_L(8); PG8_BAR; PG8_WAIT_L(0); PG8_MMA(0, 0, At, B0); PG8_BAR; PG8_SCHED;
            PG8_LDB(B1, 1, 1); PG8_STAGE(PG8_SB(1, 0), b3, voffB);
            PG8_BAR; PG8_WAIT_L(0); PG8_MMA(0, 1, At, B1); PG8_BAR;
            PG8_LDA(At, 1, 1); PG8_STAGE(PG8_SA(1, 0), a3, voffA);
            PG8_BAR; PG8_WAIT_L(0); PG8_MMA(1, 0, At, B0); PG8_BAR; PG8_SCHED;
            PG8_STAGE(PG8_SB(1, 1), b3 + hstep, voffB);
            PG8_WAIT_V(6); PG8_BAR; PG8_MMA(1, 1, At, B1); PG8_BAR;
            }
        }
        if constexpr (ALIGN_EPI) { if (wr == 0) PG8_BAR; }
        if constexpr (!Epi::AFTER_DRAIN) { E(acc, cur, wr, wc, fr, fq); S.done(cur); }
        if (!has_next) break;
#pragma unroll
        for (int a = 0; a < 2; ++a)
#pragma unroll
            for (int b = 0; b < 2; ++b)
#pragma unroll
                for (int m = 0; m < 4; ++m)
#pragma unroll
                    for (int n = 0; n < 2; ++n) acc[a][b][m][n] = (f32x4){0.f, 0.f, 0.f, 0.f};
        cur = nxt; cA = nA; cB = nB; ++ui;
        if constexpr (ALIGN_EPI) { if (wr == 1) PG8_BAR; }
    }
    PG8_WAIT_V(0);
    if constexpr (!ALIGN_EPI) { if (wr == 0) PG8_BAR; }
    PG8_BAR;
    if constexpr (Epi::AFTER_DRAIN) { E.fused(acc, cur, wr, wc, fr, fq, lds, wid, lane); S.done(cur); }
#undef PG8_SA
#undef PG8_SB
#undef PG8_STAGE
#undef PG8_LDA
#undef PG8_LDB
#undef PG8_MMA
#undef PG8_WAIT_V
#undef PG8_WAIT_L
#undef PG8_BAR
#undef PG8_SCHED
}
}

#ifndef PG8_SP2
#define PG8_SP2 true
#endif
#ifndef PG8_ALIGN
#define PG8_ALIGN true
#endif
namespace pg8 {
struct EpiF32 {
    static constexpr bool PERM = false, AFTER_DRAIN = false;
    static __device__ __forceinline__ int arow(int pm) { return pm * BM; }
    float* O; int ldc;
    __device__ __forceinline__ void operator()(const f32x4 (&acc)[2][2][4][2], const Unit& u, int wr, int wc, int fr, int fq) const {
        const int col0 = u.pn * BM + wc * 32 + 4 * fq;
#pragma unroll
        for (int ai = 0; ai < 2; ++ai)
#pragma unroll
            for (int m = 0; m < 4; ++m) { float* rowp = O + (size_t)(u.pm * BM + ai * HALF + wr * 64 + m * 16 + fr) * ldc + col0;
#pragma unroll
                for (int bj = 0; bj < 2; ++bj)
#pragma unroll
                    for (int n = 0; n < 2; ++n) *(f32x4*)(rowp + bj * HALF + n * 16) = acc[ai][bj][m][n]; }
    }
};

__device__ __forceinline__ float dpp_ror1(float x) { return __builtin_bit_cast(float, __builtin_amdgcn_update_dpp(0, __builtin_bit_cast(int, x), 0x121, 0xf, 0xf, false)); }
__device__ __forceinline__ float dpp_ror2(float x) { return __builtin_bit_cast(float, __builtin_amdgcn_update_dpp(0, __builtin_bit_cast(int, x), 0x122, 0xf, 0xf, false)); }
struct EpiConvGate {
    static constexpr bool PERM = true, AFTER_DRAIN = false;
    static constexpr int TPB = 17, SEQ_ = 4096, FF_ = 2816;
    static __device__ __forceinline__ int arow(int pm) { const int b = pm / TPB, jj = pm - TPB * b; return b * SEQ_ + 254 * jj - 2; }
    bf16_t* Hh; const float* cw; const float* cb; PG8_LAS float* ex;
    __device__ __forceinline__ void operator()(const f32x4 (&acc)[2][2][4][2], const Unit& u, int wr, int wc, int fr, int fq) const {
        const int b = u.pm / TPB, jj = u.pm - TPB * b, s0 = 254 * jj - 2;
        const int c0 = u.pn * 128 + wc * 32 + 8 * fq, wv = wr * 4 + wc;
        if (fr >= 14) {
#pragma unroll
            for (int ai = 0; ai < 2; ++ai) { PG8_LAS f32x4* p = (PG8_LAS f32x4*)(ex + ((((wv * 2 + ai) * 2 + (fr - 14)) * 4 + fq) * 16));
                p[0] = acc[ai][0][3][0]; p[1] = acc[ai][0][3][1]; p[2] = acc[ai][1][3][0]; p[3] = acc[ai][1][3][1]; }
        }
        asm volatile("s_waitcnt lgkmcnt(0)" ::: "memory"); __builtin_amdgcn_s_barrier(); asm volatile("" ::: "memory");
        f32x4 w[3][4], bb[4];
#pragma unroll
        for (int q = 0; q < 4; ++q) { const int ch = (q >> 1) * FF_ + c0 + 4 * (q & 1); bb[q] = *(const f32x4*)(cb + ch);
#pragma unroll
            for (int j = 0; j < 3; ++j) w[j][q] = *(const f32x4*)(cw + j * 2 * FF_ + ch); }
        const bool s15 = fr == 15, s14 = fr >= 14;
#pragma unroll
        for (int ai = 0; ai < 2; ++ai) {
            f32x4 e0 = (f32x4){0.f, 0.f, 0.f, 0.f}, e1 = e0, e2 = e0, e3 = e0;
            const int pai = wr ? ai : ai - 1;
            if (pai >= 0) { const PG8_LAS f32x4* e = (const PG8_LAS f32x4*)(ex + (((((1 - wr) * 4 + wc) * 2 + pai) * 2 + (fr & 1)) * 4 + fq) * 16);
                e0 = e[0]; e1 = e[1]; e2 = e[2]; e3 = e[3]; }
#pragma unroll
            for (int m = 0; m < 4; ++m) {
                const bool zc = (jj == 0 && ai == 0 && m == 0 && wr == 0 && fr < 2);
                float hh[8];
#pragma unroll
                for (int k = 0; k < 8; ++k) {
                    float yy[2];
#pragma unroll
                    for (int gvs = 0; gvs < 2; ++gvs) {
                        const int q = 2 * gvs + (k >> 2), e = k & 3;
                        const float xr = acc[ai][gvs][m][k >> 2][e];
                        const float xv = zc ? 0.f : xr;
                        float pv;
                        if (m == 0) pv = (q == 0 ? e0[e] : q == 1 ? e1[e] : q == 2 ? e2[e] : e3[e]); else pv = acc[ai][gvs][m == 0 ? 0 : m - 1][k >> 2][e];
                        const float a1 = dpp_ror1(s15 ? pv : xv), a2 = dpp_ror2(s14 ? pv : xv);
                        yy[gvs] = __builtin_fmaf(w[0][q][e], a2, __builtin_fmaf(w[1][q][e], a1, __builtin_fmaf(w[2][q][e], xv, bb[q][e])));
                    }
                    hh[k] = yy[0] * __builtin_amdgcn_rcpf(1.0f + __builtin_amdgcn_exp2f(-1.4426950408889634f * yy[0])) * yy[1];
                }
                const int i = ai * HALF + wr * 64 + m * 16 + fr, sp = s0 + i;
                u32x4 o;
                o.x = cvt_pk_bf16(hh[0], hh[1]); o.y = cvt_pk_bf16(hh[2], hh[3]); o.z = cvt_pk_bf16(hh[4], hh[5]); o.w = cvt_pk_bf16(hh[6], hh[7]);
                if (i >= 2 && sp < SEQ_) *(u32x4*)(Hh + (size_t)(b * SEQ_ + sp) * FF_ + c0) = o;
            }
        }
    }
};
}


namespace attn_body {
using bf16=__hip_bfloat16;
using bf16x8=__attribute__((ext_vector_type(8)))short;
using s16x4=__attribute__((ext_vector_type(4)))short;
using f32x16=__attribute__((ext_vector_type(16)))float;
using u32x4=__attribute__((ext_vector_type(4)))unsigned;
constexpr int BATCH=4,NHEAD=16,SEQ=4096,D=64,DM=NHEAD*D;
constexpr int NW=8,QBLK=32,QB=QBLK*NW,KVBLK=64,NQB=SEQ/QB;
constexpr int ATTN_PITCH=DM, ATTN_UNIT_ROWS=QB;
__device__ __forceinline__ int crow(int r,int hi){return (r&3)+8*(r>>2)+4*hi;}
#define SBAR() __builtin_amdgcn_sched_barrier(0)
__device__ __forceinline__ void cmask(f32x16&p0,f32x16&p1,int jb,int qrel,int hi){
  const float NEG=-INFINITY; int kb=64*jb+4*hi;
  #pragma unroll
  for(int r=0;r<16;++r){int kv=kb+(r&3)+8*(r>>2); if(kv>qrel)p0[r]=NEG; if(kv+32>qrel)p1[r]=NEG;}
}

constexpr int NSLOT=3, SLOTB=8192;
constexpr int LDS_K=0, LDS_V=NSLOT*SLOTB, LDS_WS=2*NSLOT*SLOTB, LDS_OST=LDS_WS+NW*64*4, LDS_BI=LDS_OST+NW*4096, SLOTBI=2048, LDS_BYTES=LDS_BI+NSLOT*SLOTBI;
constexpr float C2=0.125f*1.4426950408889634f;
__device__ __forceinline__ void glds16(const void*gsrc,unsigned lds_dst){unsigned keep;
  asm volatile("s_mov_b32 %0, m0\n\ts_mov_b32 m0, %2\n\ts_nop 0\n\tglobal_load_lds_dwordx4 %1, off\n\ts_mov_b32 m0, %0":"=&s"(keep):"v"(gsrc),"s"(lds_dst):"memory");}
__device__ __forceinline__ void glds4(const void*gsrc,unsigned lds_dst){unsigned keep;
  asm volatile("s_mov_b32 %0, m0\n\ts_mov_b32 m0, %2\n\ts_nop 0\n\tglobal_load_lds_dword %1, off\n\ts_mov_b32 m0, %0":"=&s"(keep):"v"(gsrc),"s"(lds_dst):"memory");}
__device__ __forceinline__ float max3f(float a,float b,float c){float r;asm("v_max3_f32 %0, %1, %2, %3":"=v"(r):"v"(a),"v"(b),"v"(c));return r;}
__device__ __forceinline__ float max2f(float a,float b){float r;asm("v_max_f32_e32 %0, %1, %2":"=v"(r):"v"(a),"v"(b));return r;}
__device__ __forceinline__ float fadd_s(float a,float b){float r;asm("v_add_f32_e32 %0, %1, %2":"=v"(r):"v"(a),"v"(b));return r;}
__device__ __forceinline__ float fsub_s(float a,float b){float r;asm("v_sub_f32_e32 %0, %1, %2":"=v"(r):"v"(a),"v"(b));return r;}
typedef float f32x2_t __attribute__((ext_vector_type(2))); typedef __bf16 bf16x2_t __attribute__((ext_vector_type(2)));
__device__ __forceinline__ unsigned cvtpk_s(float lo,float hi){f32x2_t v={lo,hi};bf16x2_t b=__builtin_convertvector(v,bf16x2_t);return __builtin_bit_cast(unsigned,b);}
#define WAIT_BAR(N) asm volatile("s_waitcnt vmcnt(" #N ") lgkmcnt(0)\n\ts_barrier":::"memory")

template<bool BIAS> __device__ __forceinline__ void qkt(f32x16&p0,f32x16&p1,const char*Kslot,const bf16x8*qr,const f32x16&negm,int r32,int hi,bf16x8 kb0,bf16x8 kb1,bf16x8 qones){
  const char*kb=Kslot+hi*1024+r32*16;
  #pragma unroll
  for(int d0=0;d0<4;++d0){
    const bf16x8 b0=*reinterpret_cast<const bf16x8*>(kb+d0*2048);
    const bf16x8 b1=*reinterpret_cast<const bf16x8*>(kb+d0*2048+512);
    if(d0==0){ if(BIAS){const f32x16 z=f32x16{};p0=__builtin_amdgcn_mfma_f32_32x32x16_bf16(b0,qr[0],z,0,0,0);p1=__builtin_amdgcn_mfma_f32_32x32x16_bf16(b1,qr[0],z,0,0,0);}
      else{p0=__builtin_amdgcn_mfma_f32_32x32x16_bf16(b0,qr[0],negm,0,0,0);p1=__builtin_amdgcn_mfma_f32_32x32x16_bf16(b1,qr[0],negm,0,0,0);} }
    else{p0=__builtin_amdgcn_mfma_f32_32x32x16_bf16(b0,qr[d0],p0,0,0,0);p1=__builtin_amdgcn_mfma_f32_32x32x16_bf16(b1,qr[d0],p1,0,0,0);}}
  if(BIAS){p0=__builtin_amdgcn_mfma_f32_32x32x16_bf16(kb0,qones,p0,0,0,0);p1=__builtin_amdgcn_mfma_f32_32x32x16_bf16(kb1,qones,p1,0,0,0);}
}
typedef __attribute__((address_space(3))) const char* lds_cptr;
typedef short v4i16_t __attribute__((ext_vector_type(4)));
__device__ __forceinline__ void kload8(bf16x8*kf,lds_cptr kp){
  kf[0]=*(const __attribute__((address_space(3))) bf16x8*)(kp);      kf[1]=*(const __attribute__((address_space(3))) bf16x8*)(kp+512);
  kf[2]=*(const __attribute__((address_space(3))) bf16x8*)(kp+2048); kf[3]=*(const __attribute__((address_space(3))) bf16x8*)(kp+2560);
  kf[4]=*(const __attribute__((address_space(3))) bf16x8*)(kp+4096); kf[5]=*(const __attribute__((address_space(3))) bf16x8*)(kp+4608);
  kf[6]=*(const __attribute__((address_space(3))) bf16x8*)(kp+6144); kf[7]=*(const __attribute__((address_space(3))) bf16x8*)(kp+6656);
}
__device__ __forceinline__ void kload2(bf16x8*kf,lds_cptr kp,int j){ kf[2*j]=*(const __attribute__((address_space(3))) bf16x8*)(kp+j*2048); kf[2*j+1]=*(const __attribute__((address_space(3))) bf16x8*)(kp+j*2048+512); }
__device__ __forceinline__ s16x4 vtr(lds_cptr p){ return __builtin_bit_cast(s16x4,__builtin_amdgcn_ds_read_tr16_b64_v4i16((__attribute__((address_space(3))) v4i16_t*)p)); }
__device__ __forceinline__ float rowmax(const f32x16&p0,const f32x16&p1){
  float a=max3f(p0[0],p0[1],p1[0]),b=max3f(p0[2],p0[3],p1[1]);a=max3f(a,p1[2],p1[3]);
  #pragma unroll
  for(int r=4;r<16;r+=4){a=max3f(a,p0[r],p0[r+1]);b=max3f(b,p0[r+2],p0[r+3]);a=max3f(a,p1[r],p1[r+1]);b=max3f(b,p1[r+2],p1[r+3]);}
  const float m=max2f(a,b);
  auto rr=__builtin_amdgcn_permlane32_swap(__float_as_uint(m),__float_as_uint(m),false,false);
  return max2f(__uint_as_float(rr[0]),__uint_as_float(rr[1]));
}
__device__ __forceinline__ void pv(f32x16*o,int vb,bf16x8 pa0,bf16x8 pa1,bf16x8 pa2,bf16x8 pa3){
  #pragma unroll
  for(int d0=0;d0<2;++d0){s16x4 lo[4],hi[4];
    #pragma unroll
    for(int ks=0;ks<4;++ks){
      asm volatile("ds_read_b64_tr_b16 %0,%1 offset:%c2":"=&v"(lo[ks]):"v"(vb),"i"(d0*4096+ks*1024):"memory");
      asm volatile("ds_read_b64_tr_b16 %0,%1 offset:%c2":"=&v"(hi[ks]):"v"(vb),"i"(d0*4096+ks*1024+512):"memory");}
    asm volatile("s_waitcnt lgkmcnt(0)":::"memory");SBAR();
    #define PK(k) (bf16x8){lo[k][0],lo[k][1],lo[k][2],lo[k][3],hi[k][0],hi[k][1],hi[k][2],hi[k][3]}
    o[d0]=__builtin_amdgcn_mfma_f32_32x32x16_bf16(pa0,PK(0),o[d0],0,0,0);
    o[d0]=__builtin_amdgcn_mfma_f32_32x32x16_bf16(pa1,PK(1),o[d0],0,0,0);
    o[d0]=__builtin_amdgcn_mfma_f32_32x32x16_bf16(pa2,PK(2),o[d0],0,0,0);
    o[d0]=__builtin_amdgcn_mfma_f32_32x32x16_bf16(pa3,PK(3),o[d0],0,0,0);
    #undef PK
  }
}

#ifndef ATTN_STORE16
#define ATTN_STORE16(p,v) (*(u32x4*)(p)=(v))
#endif
template<int THRL,bool BIAS,bool DIFF> __device__ __forceinline__ void attn_unit(int b,int hq,int hv,int qb,const bf16*Q,const bf16*__restrict__ K,const bf16*__restrict__ V,bf16*O,char*shm,const unsigned char*BT,float*S,int combine,float lam){
  int tid_=threadIdx.x; asm volatile("":"+v"(tid_));
  const int tid=tid_,lane=tid&63,r32=lane&31,hi=lane>>5; const int wid=__builtin_amdgcn_readfirstlane(tid>>6);
  const long rowbase=(long)b*SEQ; const int q0=qb*QB;
  const bf16*Qw=Q+(rowbase+q0+wid*QBLK)*DM+hq*D;
  const bf16*Kh=K+rowbase*DM+hq*D,*Vh=V+rowbase*DM+hv*D;
  const unsigned lds0=(unsigned)(uintptr_t)shm;
  float*wsf=(float*)(shm+LDS_WS)+wid*64;
  const bf16*ksrc=Kh+(long)lane*DM+wid*8;
  const bf16*vsrc=Vh+(long)(16*(wid&3)+(lane>>2))*DM+(wid>>2)*32+(lane&3)*8;
  const unsigned kdst=lds0+LDS_K+wid*1024, vdst=lds0+LDS_V+wid*1024;
  #define DMA_K(t,slot) glds16(ksrc+(long)(t)*KVBLK*DM,(unsigned)__builtin_amdgcn_readfirstlane(kdst+(slot)))
  #define DMA_V(t,slot) glds16(vsrc+(long)(t)*KVBLK*DM,(unsigned)__builtin_amdgcn_readfirstlane(vdst+(slot)))
  const unsigned char*bsrc=BT+((long)(b*NHEAD+hq)*SEQ)*32+wid*256+lane*4; const unsigned bdst=lds0+LDS_BI+wid*256;
  #define DMA_B(t,slot) glds4(bsrc+(long)(t)*2048,(unsigned)__builtin_amdgcn_readfirstlane(bdst+((slot)>>2)))
  const lds_cptr bp0=(lds_cptr)shm+LDS_BI+r32*32+hi*16; bf16x8 kb0=bf16x8{},kb1=bf16x8{}; u32x4 qm={0x3F803F80u,0x00003F80u,0u,0u};
  #define qones __builtin_bit_cast(bf16x8,qm)
  #define SETREF() do{ if(BIAS){ const float nm_=-mhat; const unsigned h_=__float_as_uint(nm_)&0xffff0000u; const float r1_=nm_-__uint_as_float(h_); const unsigned m_=__float_as_uint(r1_)&0xffff0000u; const float r2_=r1_-__uint_as_float(m_); \
      qm[1]=0x3F80u|h_; qm[2]=(m_>>16)|(__float_as_uint(r2_)&0xffff0000u); } else { _Pragma("unroll") for(int r=0;r<16;++r)negm[r]=-mhat; asm volatile("":"+v"(negm)); } }while(0)
  #define BLD(slot) do{ if(BIAS){ kb0=*(const __attribute__((address_space(3))) bf16x8*)(bp0+((slot)>>2)); kb1=*(const __attribute__((address_space(3))) bf16x8*)(bp0+((slot)>>2)+1024); } }while(0)
  const int vb0=(int)(lds0+LDS_V)+((lane>>4)&1)*32+(lane&3)*8+(4*hi+((lane&15)>>2))*64;
  const char*Kbase=shm+LDS_K; bf16x8 kf[8];
  const lds_cptr shm3=(lds_cptr)shm; const lds_cptr kp0=shm3+LDS_K+hi*1024+r32*16; const lds_cptr vp0=shm3+LDS_V+((lane>>4)&1)*32+(lane&3)*8+(4*hi+((lane&15)>>2))*64;
  const int NT=(q0+QB)/KVBLK;
  DMA_K(0,0);if(BIAS){DMA_B(0,0);}DMA_V(0,0);DMA_K(1,SLOTB);if(BIAS){DMA_B(1,SLOTB);}
  bf16x8 qr[4];
  #pragma unroll
  for(int d0=0;d0<4;++d0)qr[d0]=*reinterpret_cast<const bf16x8*>(&Qw[(long)r32*DM+d0*16+hi*8]);
  float mhat=0.f,l_reg=0.f;f32x16 o[2];o[0]=f32x16{};o[1]=f32x16{};f32x16 negm=f32x16{}; if(!BIAS){asm volatile("":"+v"(negm));}
  const int qrel=wid*QBLK+r32;
  #define CMASK(P0,P1,t) do{int jb_=(t)-(NT-4); if(DIFF){ if(jb_>(wid>>1)){ _Pragma("unroll") for(int r_=0;r_<16;++r_){P0[r_]=-INFINITY;P1[r_]=-INFINITY;} } } else { if(jb_>=0)cmask(P0,P1,jb_,qrel,hi); } }while(0)
  bool resc=false;
  #define START(P0,P1) do{ const float rm=rowmax(P0,P1); resc=false; \
    { const float dl=rm; mhat=fadd_s(mhat,dl); \
      _Pragma("unroll") for(int r=0;r<16;++r){P0[r]=fsub_s(P0[r],dl);P1[r]=fsub_s(P1[r],dl);} \
      SETREF(); } \
    _Pragma("unroll") for(int r=0;r<16;++r)P0[r]=__builtin_amdgcn_exp2f(P0[r]); }while(0)
  #define RESC() do{ if(resc){ asm volatile("s_waitcnt lgkmcnt(0)":::"memory"); \
      _Pragma("unroll") for(int d_=0;d_<2;++d_) _Pragma("unroll") for(int r=0;r<16;++r)o[d_][r]*=wsf[crow(r,hi)]; } }while(0)
  f32x16 pA0,pA1,pB0,pB1;
  int sl_prev=0,sl_cur=0,sl_next=SLOTB;
  #define ROT() do{sl_prev=sl_cur;sl_cur=sl_next;sl_next=(sl_next==(NSLOT-1)*SLOTB)?0:sl_next+SLOTB;}while(0)
  DMA_K(2,2*SLOTB);
  if(BIAS){WAIT_BAR(4);}else{WAIT_BAR(3);}
  if(BIAS){DMA_B(2,2*SLOTB);BLD(0);}
  qkt<BIAS>(pA0,pA1,Kbase,qr,negm,r32,hi,kb0,kb1,qones);asm volatile("s_nop 15\n\ts_nop 7":"+v"(pA0),"+v"(pA1));CMASK(pA0,pA1,0);
  START(pA0,pA1);
  _Pragma("unroll") for(int r=0;r<16;++r)pA1[r]=__builtin_amdgcn_exp2f(pA1[r]);
  WAIT_BAR(0);
  DMA_K(3,0);DMA_V(1,SLOTB);
  ROT();
  kload8(kf,kp0+sl_cur);
  WAIT_BAR(2);
  s16x4 vlo[8],vhi[8]; u32x4 pw0,pw1,pw2,pw3;
  #define PKW(P,B) cvtpk_s(P[B],P[B+1])
  #define PAF(k) __builtin_bit_cast(bf16x8,pw##k)
  #define VFR(i) (bf16x8){vlo[i][0],vlo[i][1],vlo[i][2],vlo[i][3],vhi[i][0],vhi[i][1],vhi[i][2],vhi[i][3]}
  #define PIN(x) asm volatile("":"+v"(x))
  #define MX3(a,b,c) __builtin_fmaxf(__builtin_fmaxf((a),(b)),(c))
  #define GAPA(MF,A0,A1,A2,A3,W0,W1,PW) do{ MF; sacc+=A0; sacc+=A1; sacc+=A2; sacc+=A3; PIN(sacc); W0; W1; PIN(PW); SBAR(); }while(0)
  #define EX(v) __builtin_amdgcn_exp2f(v)
  #define GAPB(MF,X,B) do{ MF; X[B]=EX(X[B]); X[B+1]=EX(X[B+1]); X[B+2]=EX(X[B+2]); X[B+3]=EX(X[B+3]); PIN(X); SBAR(); }while(0)
  #define VRD(i) do{ vlo[i]=vtr(vp_+(((i)>>2)*4096+((i)&3)*1024)); vhi[i]=vtr(vp_+(((i)>>2)*4096+((i)&3)*1024+512)); }while(0)
  #define KRD(G,j) do{ if(G){ kload2(kf,kp0+sl_next,j); SBAR(); } }while(0)
  #define CINIT (BIAS?f32x16{}:negm)
  #define STEP(C0,C1,P0,P1,t,GK,GV,GL,GB) do{ SBAR(); \
    if(BIAS){ if(GB){DMA_B((t)+2,sl_prev);} BLD(sl_cur); } \
    const lds_cptr vp_=vp0+sl_prev; \
    VRD(0); SBAR(); float sacc=(P0[0]+P0[1]); \
    GAPA(C0=__builtin_amdgcn_mfma_f32_32x32x16_bf16(kf[0],qr[0],CINIT,0,0,0), P0[2],P0[3],P0[4],P0[5],     pw0[0]=PKW(P0,0), pw0[1]=PKW(P0,2), pw0); \
    VRD(4); SBAR(); GAPA(C1=__builtin_amdgcn_mfma_f32_32x32x16_bf16(kf[1],qr[0],CINIT,0,0,0), P0[6],P0[7],P0[8],P0[9],     pw0[2]=PKW(P0,4), pw0[3]=PKW(P0,6), pw0); \
    VRD(1); SBAR(); GAPA(C0=__builtin_amdgcn_mfma_f32_32x32x16_bf16(kf[2],qr[1],C0,0,0,0),   P0[10],P0[11],P0[12],P0[13], pw1[0]=PKW(P0,8), pw1[1]=PKW(P0,10), pw1); \
    VRD(5); SBAR(); GAPA(C1=__builtin_amdgcn_mfma_f32_32x32x16_bf16(kf[3],qr[1],C1,0,0,0),   P0[14],P0[15],P1[0],P1[1],   pw1[2]=PKW(P0,12),pw1[3]=PKW(P0,14), pw1); \
    VRD(2); SBAR(); GAPA(C0=__builtin_amdgcn_mfma_f32_32x32x16_bf16(kf[4],qr[2],C0,0,0,0),   P1[2],P1[3],P1[4],P1[5],     pw2[0]=PKW(P1,0), pw2[1]=PKW(P1,2), pw2); \
    VRD(6); SBAR(); GAPA(C1=__builtin_amdgcn_mfma_f32_32x32x16_bf16(kf[5],qr[2],C1,0,0,0),   P1[6],P1[7],P1[8],P1[9],     pw2[2]=PKW(P1,4), pw2[3]=PKW(P1,6), pw2); \
    VRD(3); SBAR(); GAPA(C0=__builtin_amdgcn_mfma_f32_32x32x16_bf16(kf[6],qr[3],C0,0,0,0),   P1[10],P1[11],P1[12],P1[13], pw3[0]=PKW(P1,8), pw3[1]=PKW(P1,10), pw3); \
    VRD(7); SBAR(); GAPA(C1=__builtin_amdgcn_mfma_f32_32x32x16_bf16(kf[7],qr[3],C1,0,0,0),   P1[14],P1[15],0.f,0.f,       pw3[2]=PKW(P1,12),pw3[3]=PKW(P1,14), pw3); \
    if(BIAS){ C0=__builtin_amdgcn_mfma_f32_32x32x16_bf16(kb0,qones,C0,0,0,0); C1=__builtin_amdgcn_mfma_f32_32x32x16_bf16(kb1,qones,C1,0,0,0); } \
    l_reg+=sacc; \
    if(GK){DMA_K((t)+3,sl_cur);} if(GV){DMA_V((t)+1,sl_next);} \
    CMASK(C0,C1,t); \
    { float a=MX3(C0[0],C0[1],C1[0]),b=MX3(C0[2],C0[3],C1[1]); a=MX3(a,C1[2],C1[3]); \
      _Pragma("unroll") for(int r=4;r<16;r+=4){a=MX3(a,C0[r],C0[r+1]);b=MX3(b,C0[r+2],C0[r+3]);a=MX3(a,C1[r],C1[r+1]);b=MX3(b,C1[r+2],C1[r+3]);} \
      float rm=__builtin_fmaxf(a,b); { auto rr=__builtin_amdgcn_permlane32_swap(__float_as_uint(rm),__float_as_uint(rm),false,false); rm=__builtin_fmaxf(__uint_as_float(rr[0]),__uint_as_float(rr[1])); } \
      resc=false; \
      if(__builtin_expect(__any(rm>(float)THRL),0)){ const float dl=__builtin_fmaxf(rm,0.f); mhat+=dl; \
        _Pragma("unroll") for(int r=0;r<16;++r){C0[r]-=dl;C1[r]-=dl;} \
        SETREF(); \
        const float f=__builtin_amdgcn_exp2f(-dl); l_reg*=f; if(hi==0)wsf[r32]=f; resc=true; } } \
    SBAR(); \
    GAPB(o[0]=__builtin_amdgcn_mfma_f32_32x32x16_bf16(PAF(0),VFR(0),o[0],0,0,0), C0,0); \
    GAPB(o[1]=__builtin_amdgcn_mfma_f32_32x32x16_bf16(PAF(0),VFR(4),o[1],0,0,0), C0,4); \
    KRD(GL,0); GAPB(o[0]=__builtin_amdgcn_mfma_f32_32x32x16_bf16(PAF(1),VFR(1),o[0],0,0,0), C0,8); \
    KRD(GL,1); GAPB(o[1]=__builtin_amdgcn_mfma_f32_32x32x16_bf16(PAF(1),VFR(5),o[1],0,0,0), C0,12); \
    KRD(GL,2); GAPB(o[0]=__builtin_amdgcn_mfma_f32_32x32x16_bf16(PAF(2),VFR(2),o[0],0,0,0), C1,0); \
    KRD(GL,3); GAPB(o[1]=__builtin_amdgcn_mfma_f32_32x32x16_bf16(PAF(2),VFR(6),o[1],0,0,0), C1,4); \
    GAPB(o[0]=__builtin_amdgcn_mfma_f32_32x32x16_bf16(PAF(3),VFR(3),o[0],0,0,0), C1,8); \
    GAPB(o[1]=__builtin_amdgcn_mfma_f32_32x32x16_bf16(PAF(3),VFR(7),o[1],0,0,0), C1,12); \
    }while(0)
  int t=1;
  #undef CMASK
  #define CMASK(P0,P1,t) do{}while(0)
  for(;t+5<NT;t+=2){
    STEP(pB0,pB1,pA0,pA1,t,true,true,true,true);     WAIT_BAR(2); RESC(); ROT();
    STEP(pA0,pA1,pB0,pB1,t+1,true,true,true,true);   WAIT_BAR(2); RESC(); ROT();
  }
  #undef CMASK
  #define CMASK(P0,P1,t) do{int jb_=(t)-(NT-4); if(DIFF){ if(jb_>(wid>>1)){ _Pragma("unroll") for(int r_=0;r_<16;++r_){P0[r_]=-INFINITY;P1[r_]=-INFINITY;} } } else { if(jb_>=0)cmask(P0,P1,jb_,qrel,hi); } }while(0)
  #define ENDW(tt) do{ if((tt)+3<NT){WAIT_BAR(2);} else if((tt)+2<NT){WAIT_BAR(1);} else {WAIT_BAR(0);} }while(0)
  for(;t+1<NT;t+=2){
    STEP(pB0,pB1,pA0,pA1,t,(t+3<NT),(t+1<NT),(t+1<NT),(t+2<NT));       ENDW(t);   RESC(); ROT();
    STEP(pA0,pA1,pB0,pB1,t+1,(t+4<NT),(t+2<NT),(t+2<NT),(t+3<NT));     ENDW(t+1); RESC(); ROT();
  }
  STEP(pB0,pB1,pA0,pA1,NT-1,false,false,false,false); RESC();
  { float sacc=pB0[0]+pB0[1]; _Pragma("unroll") for(int r=2;r<16;++r)sacc+=pB0[r]; _Pragma("unroll") for(int r=0;r<16;++r)sacc+=pB1[r]; l_reg+=sacc;
    pw0=(u32x4){PKW(pB0,0),PKW(pB0,2),PKW(pB0,4),PKW(pB0,6)};pw1=(u32x4){PKW(pB0,8),PKW(pB0,10),PKW(pB0,12),PKW(pB0,14)};pw2=(u32x4){PKW(pB1,0),PKW(pB1,2),PKW(pB1,4),PKW(pB1,6)};pw3=(u32x4){PKW(pB1,8),PKW(pB1,10),PKW(pB1,12),PKW(pB1,14)};
    SBAR(); pv(o,vb0+sl_cur,PAF(0),PAF(1),PAF(2),PAF(3)); }
  #undef PKW
  #undef PAF
  #undef VFR
  #undef PIN
  #undef MX3
  #undef GAPA
  #undef GAPB
  #undef EX
  #undef VRD
  #undef KRD
  #undef STEP
  #undef ENDW
  {auto rr=__builtin_amdgcn_permlane32_swap(__float_as_uint(l_reg),__float_as_uint(l_reg),false,false);l_reg=__uint_as_float(rr[0])+__uint_as_float(rr[1]);}
  if(hi==0)wsf[32+r32]=l_reg;asm volatile("s_waitcnt lgkmcnt(0)":::"memory");
  float rli[16];
  #pragma unroll
  for(int r=0;r<16;++r)rli[r]=__builtin_amdgcn_rcpf(wsf[32+crow(r,hi)]);
  if(DIFF){ float*Sw=S+(rowbase+q0+wid*QBLK)*DM+hv*D;
    #pragma unroll
    for(int r=0;r<16;++r){ float*sp=Sw+(long)crow(r,hi)*DM+r32;
      #pragma unroll
      for(int d0=0;d0<2;++d0){ float v=o[d0][r]*rli[r]; if(combine)v=sp[d0*32]-lam*v; sp[d0*32]=v; } } }
  else { bf16*Ow=O+(rowbase+q0+wid*QBLK)*DM+hq*D;
    bf16*stg=(bf16*)(shm+LDS_OST)+wid*2048;
    #pragma unroll
    for(int r=0;r<16;++r){const int orow=crow(r,hi);
      #pragma unroll
      for(int d0=0;d0<2;++d0)stg[orow*64+d0*32+r32]=__float2bfloat16(o[d0][r]*rli[r]);}
    asm volatile("s_waitcnt lgkmcnt(0)":::"memory");
    #pragma unroll
    for(int i=0;i<4;++i){const int row=i*8+(lane>>3),ch=lane&7; const u32x4 v=*(const u32x4*)(stg+row*64+ch*8); ATTN_STORE16(Ow+(long)row*DM+ch*8,v);} }
  asm volatile("s_waitcnt lgkmcnt(0)\n\ts_barrier":::"memory");
  #undef DMA_K
  #undef DMA_V
  #undef DMA_B
  #undef BLD
  #undef qones
  #undef SETREF
  #undef CINIT
  #undef CMASK
  #undef START
  #undef RESC
  #undef ROT
}
constexpr int ATTN_LDS_BYTES=LDS_BYTES;
struct AttnTensors { const bf16* Q; const bf16* K; const bf16* V; bf16* O; };
struct AttnUnit { int bh; int qb; };
struct StaticOrder {
  int vcu;
  __device__ __forceinline__ explicit StaticOrder(int grid,int block):vcu((block%8)*(grid/8)+block/8){}
  __device__ __forceinline__ bool next(int i,AttnUnit&u)const{ if(i>=4)return false; const int s=vcu&3; u.bh=vcu>>2; u.qb=(i==0)?s:(i==1)?7-s:(i==2)?8+s:15-s; return true; }
  __device__ __forceinline__ void a_ready(const AttnUnit&)const{}
  __device__ __forceinline__ void done(const AttnUnit&)const{}
};
template<class Sched,int THRL,bool BIAS> __device__ __forceinline__ void attn_phase(char*lds,const AttnTensors&T,const Sched&S,const unsigned char*BT){
  AttnUnit u;
  for(int i=0;S.next(i,u);++i){ S.a_ready(u); attn_unit<THRL,BIAS,false>(u.bh/NHEAD,u.bh%NHEAD,u.bh%NHEAD,u.qb,T.Q,T.K,T.V,T.O,lds,BT,nullptr,0,0.f); S.done(u); }
}
template<int THRL> __device__ __forceinline__ void diff_phase(char*lds,const bf16*Q1,const bf16*K12,const bf16*V,float*S,float lam,int grid,int block){
  const int vcu=(block%8)*(grid/8)+block/8, s=vcu&7, bh=vcu>>3, b=bh>>3, h8=bh&7;
  for(int ui=0;ui<2;++ui){ const int qb=ui==0?s:15-s;
    for(int ps=0;ps<4;++ps){ const int i=ps&1, j=ps>>1; attn_unit<THRL,false,true>(b,i*8+h8,2*h8+j,qb,Q1,K12,V,nullptr,lds,nullptr,S,i,lam); } }
}
#undef SBAR
#undef WAIT_BAR
}
#define GAS __attribute__((address_space(1)))
#define LAS __attribute__((address_space(3)))
typedef unsigned short bf16;
typedef unsigned v4u __attribute__((ext_vector_type(4)));
typedef float f32x4 __attribute__((ext_vector_type(4)));
typedef short bf16x8 __attribute__((ext_vector_type(8)));
typedef GAS unsigned gu32;
typedef GAS unsigned long long gu64;
#define RLX_AGENT __ATOMIC_RELAXED, __HIP_MEMORY_SCOPE_AGENT
#define LDS_WAIT() asm volatile("s_waitcnt lgkmcnt(0)" ::: "memory")
#define VM_WAIT() asm volatile("s_waitcnt vmcnt(0)" ::: "memory")
__device__ __forceinline__ unsigned long long rt() { return __builtin_amdgcn_s_memrealtime(); }
__device__ __forceinline__ unsigned f2bf(float f) { unsigned u = __builtin_bit_cast(unsigned, f); return (u + 0x7fffu + ((u >> 16) & 1u)) >> 16; }
__device__ __forceinline__ unsigned pk2(float lo, float hi) { return f2bf(lo) | (f2bf(hi) << 16); }

#define XB_TMO      128
#define XB_XCNT(j)  (256  + 64 * (j))
#define XB_XSUB(j)  (1280 + 64 * (j))
#define XB_XGEN(j)  (2304 + 64 * (j))
#define XB_TOP      3328
#define XB_TOPGEN   3392
#define XCD_BAR_WORDS 3456
#define XB_SPIN_CAP (1u << 18)

__device__ __forceinline__ unsigned xb_ld(unsigned* p)              { return __hip_atomic_load(p, __ATOMIC_RELAXED, __HIP_MEMORY_SCOPE_AGENT); }
__device__ __forceinline__ unsigned xb_add(unsigned* p, unsigned v) { return __hip_atomic_fetch_add(p, v, __ATOMIC_RELAXED, __HIP_MEMORY_SCOPE_AGENT); }
__device__ __forceinline__ unsigned xb_xcc_id() { return (unsigned)__builtin_amdgcn_s_getreg((3 << 11) | 20) & 0xFu; }
#define XB_SPIN(cond, bar) do { unsigned _sp = 0; while (cond) { __builtin_amdgcn_s_sleep(1); \
    if ((++_sp & 255u) == 0u) { if (xb_ld(&(bar)[XB_TMO])) break; if (_sp > XB_SPIN_CAP) { atomicAdd(&(bar)[XB_TMO], 1u); break; } } } } while (0)

struct XcdBarrier {
    unsigned* bar; unsigned x;
    volatile LAS unsigned* st;
};

__device__ __forceinline__ XcdBarrier xcd_barrier_post(unsigned* bar, volatile LAS unsigned* st) {
    XcdBarrier b; b.bar = bar; b.x = xb_xcc_id(); b.st = st;
    if (threadIdx.x == 0) (void)xb_add(&bar[XB_XCNT(b.x)], 1u);
    return b;
}
__device__ __forceinline__ void xcd_barrier_complete(unsigned* bar, unsigned x, unsigned& nloc, unsigned& nx) {
    const unsigned G = gridDim.x * gridDim.y * gridDim.z;
    unsigned sum, cnt, mine, sp = 0u;
    for (;;) {
        sum = 0u; cnt = 0u; mine = 0u;
#pragma unroll
        for (unsigned j = 0; j < 16; ++j) { const unsigned c = xb_ld(&bar[XB_XCNT(j)]); sum += c; cnt += (c > 0u) ? 1u : 0u; }
        if (sum == G) break;
        __builtin_amdgcn_s_sleep(1);
        if ((++sp & 255u) == 0u) { if (xb_ld(&bar[XB_TMO])) break; if (sp > XB_SPIN_CAP) { atomicAdd(&bar[XB_TMO], 1u); break; } }
    }
    mine = xb_ld(&bar[XB_XCNT(x)]);
    nloc = mine > 0u ? mine : 1u; nx = cnt > 0u ? cnt : 1u;
}

__device__ __forceinline__ void xcd_barrier(const XcdBarrier& b) {
    asm volatile("s_waitcnt vmcnt(0)" ::: "memory");
    __syncthreads();
    if (threadIdx.x == 0) {
        unsigned* bar = b.bar; asm volatile("" : "+s"(bar));
        __builtin_amdgcn_s_waitcnt(0);
        unsigned nloc = b.st[0], nx = b.st[1];
        if (nloc == 0u) { xcd_barrier_complete(bar, b.x, nloc, nx); b.st[0] = nloc; b.st[1] = nx; }
        const unsigned old = xb_add(&bar[XB_XSUB(b.x)], 1u);
        const unsigned gen = old / nloc;
        if (old + 1u == (gen + 1u) * nloc) {
            __builtin_amdgcn_fence(__ATOMIC_RELEASE, "agent");
            asm volatile("s_waitcnt vmcnt(0)" ::: "memory");
            const unsigned og = xb_add(&bar[XB_TOP], 1u);
            const unsigned tg = og / nx;
            if (og + 1u == (tg + 1u) * nx) xb_add(&bar[XB_TOPGEN], 1u);
            else XB_SPIN(xb_ld(&bar[XB_TOPGEN]) == tg, bar);
            __builtin_amdgcn_fence(__ATOMIC_ACQUIRE, "agent");
            xb_add(&bar[XB_XGEN(b.x)], 1u);
            asm volatile("s_waitcnt vmcnt(0)" ::: "memory");
        } else {
            XB_SPIN(xb_ld(&bar[XB_XGEN(b.x)]) == gen, bar);
            __builtin_amdgcn_fence(__ATOMIC_ACQUIRE, "agent");
            asm volatile("s_waitcnt vmcnt(0)" ::: "memory");
        }
    }
    __syncthreads();
}
constexpr int NWAVES = 8;
constexpr int BATCH = 4, SEQ = 4096, D = 1024, NH = 16, HD = 64, FF = 2816, FF2 = 2 * FF, DH2 = 8, DV = 128;
constexpr int M = BATCH * SEQ;
constexpr int AWIN_LD = 3 * D + NH;
constexpr float LN_EPS = 1e-5f, RMS_EPS = 1e-5f;
constexpr float DN_ALPHA = 1.4142135623730951f;
constexpr float LAMBDA_INIT = 0.35550906759096926f;
constexpr float C2 = 0.125f * 1.4426950408889634f;
constexpr float LOG2E = 1.4426950408889634f;

constexpr size_t MiB = 1u << 20;
constexpr size_t WS_CTL = 0, CTL_ZERO_BYTES = 1 * MiB;
constexpr size_t WS_COS = 1 * MiB, WS_SIN = WS_COS + 512 * 1024;
constexpr size_t WS_FLOG = 2 * MiB;
constexpr size_t WS_CK = 3 * MiB;
constexpr size_t WS_X = 5 * MiB;
constexpr size_t WS_WQKV0 = 8 * MiB, WS_WO0 = 14 * MiB, WS_WQKV1 = 16 * MiB, WS_WO1 = 22 * MiB;
constexpr size_t WS_WIN0 = 24 * MiB, WS_WIN1 = 35 * MiB, WS_WOUT0 = 46 * MiB, WS_WOUT1 = 52 * MiB;
constexpr size_t WS_XB = 58 * MiB;
constexpr size_t WS_QO = 90 * MiB, WS_KB = 122 * MiB, WS_VB = 154 * MiB;
constexpr size_t WS_BT = 186 * MiB;
constexpr size_t WS_HS = 186 * MiB;
constexpr size_t WS_HB = 90 * MiB;
constexpr size_t WS_END = 256 * MiB;
static_assert(WS_HB + (size_t)M * FF * 2 <= WS_HS, "ffn map");
static_assert(WS_HS + (size_t)M * D * 4 <= WS_END && WS_VB + (size_t)M * D * 2 <= WS_HS && WS_XB + (size_t)M * D * 2 <= WS_QO, "attn map");
constexpr int CW_TMO = 0, CW_CODE = 1, CW_BAR = 4096, CW_SEAM = 16384, SEAM_BANK = 128 * 64;

constexpr int RING_OFF = 0, RING_BYTES = 131072;
constexpr int LDSCTL_OFF = RING_BYTES, MISC_OFF = LDSCTL_OFF + 320;
constexpr int EX_OFF = 132096;
constexpr int LDS_BYTES = 151552;
static_assert(EX_OFF >= MISC_OFF + 128 && EX_OFF + 16384 <= LDS_BYTES, "LDS map");

struct Frame {
    LAS unsigned char* lds;
    volatile LAS unsigned* MISC;
    gu32* ctl;
    int tid, lane, wave;
    int vcu, G;
};
struct Args { const float* in[17]; float* out; unsigned char* ws; };

__device__ __forceinline__ float wave_sum(float v) {
#pragma unroll
    for (int o = 1; o < 64; o <<= 1) v += __shfl_xor(v, o);
    return v;
}
__device__ __forceinline__ float bf2f(unsigned short h) { return __uint_as_float((unsigned)h << 16); }

__device__ __forceinline__ int map_row(int mode, int off, int n) {
    if (mode == 1) {
        const int g = n & ~63, d = n & 63;
        const int p = d < 32 ? 8 * (d >> 2) + (d & 3) : 8 * ((d - 32) >> 2) + 4 + (d & 3);
        return off + g + p;
    }
    if (mode == 2) {
        return n < FF ? 256 * (n >> 7) + (n & 127) : 256 * ((n - FF) >> 7) + 128 + ((n - FF) & 127);
    }
    return off + n;
}
__device__ __forceinline__ void p0_transpose_item(const float* W, int ldw, int K, int nblk, bf16* WT, int mode, int off, LAS float* scr, int item, int lane) {
    const int kb = item / nblk, nb = item % nblk, k0 = 64 * kb, n0 = 32 * nb;
#pragma unroll 8
    for (int i = 0; i < 32; ++i) { const int kk = 2 * i + (lane >> 5); scr[kk * 33 + (lane & 31)] = W[(size_t)(k0 + kk) * ldw + n0 + (lane & 31)]; }
    LDS_WAIT(); asm volatile("" ::: "memory");
    const int c = lane & 7;
#pragma unroll
    for (int j = 0; j < 4; ++j) { const int n = (lane >> 3) + 8 * j; const LAS float* s = scr + (8 * c) * 33 + n;
        v4u o; o.x = pk2(s[0 * 33], s[1 * 33]); o.y = pk2(s[2 * 33], s[3 * 33]); o.z = pk2(s[4 * 33], s[5 * 33]); o.w = pk2(s[6 * 33], s[7 * 33]);
        *(GAS v4u*)(WT + (size_t)map_row(mode, off, n0 + n) * K + k0 + 8 * c) = o; }
    LDS_WAIT(); asm volatile("" ::: "memory");
}
__device__ __forceinline__ void sincos_d(double x, double& s, double& c) {
    const double n = __builtin_rint(x * 0.63661977236758134308);
    double r = __builtin_fma(-n, 1.57079632679489655800, x); r = __builtin_fma(-n, 6.12323399573676603587e-17, r);
    const double r2 = r * r;
    double sp = -7.6471637318198164759e-13; sp = __builtin_fma(sp, r2, 1.6059043836821614599e-10); sp = __builtin_fma(sp, r2, -2.5052108385441718775e-08);
    sp = __builtin_fma(sp, r2, 2.7557319223985890653e-06); sp = __builtin_fma(sp, r2, -1.9841269841269841270e-04); sp = __builtin_fma(sp, r2, 8.3333333333333333333e-03);
    sp = __builtin_fma(sp, r2, -1.6666666666666666667e-01); const double sr = __builtin_fma(sp * r2, r, r);
    double cp = 4.7794773323873852974e-14; cp = __builtin_fma(cp, r2, -1.1470745597729724714e-11); cp = __builtin_fma(cp, r2, 2.0876756987868098979e-09);
    cp = __builtin_fma(cp, r2, -2.7557319223985890653e-07); cp = __builtin_fma(cp, r2, 2.4801587301587301587e-05); cp = __builtin_fma(cp, r2, -1.3888888888888888889e-03);
    cp = __builtin_fma(cp, r2, 4.1666666666666666667e-02); cp = __builtin_fma(cp, r2, -0.5); const double cr = __builtin_fma(cp, r2, 1.0);
    const int q = ((int)n) & 3;
    s = (q == 0) ? sr : (q == 1) ? cr : (q == 2) ? -sr : -cr;
    c = (q == 0) ? cr : (q == 1) ? -sr : (q == 2) ? -cr : sr;
}

__device__ __forceinline__ void p0_prologue(Frame& F, const Args& args) {
    unsigned char* ws = args.ws;
    LAS float* scr = (LAS float*)(F.lds + RING_OFF + F.wave * 16384);
    const int gw = F.vcu * NWAVES + F.wave, NGW = F.G * NWAVES;
    constexpr int I0 = 16 * 96, I1 = 16 * 32, I7 = 16 * 176, I9 = 44 * 32;
    constexpr int NITEMS = I0 + 5 * I1 + 2 * I7 + 2 * I9;
    for (int it = gw; it < NITEMS; it += NGW) {
        int r = it; const float* W; int ldw, K, nblk, mode = 0, off = 0; size_t dst;
        if (r < I0) { W = args.in[1]; ldw = AWIN_LD; K = D; nblk = 96; dst = WS_WQKV0; }
        else if ((r -= I0) < I1) { W = args.in[3]; ldw = D; K = D; nblk = 32; dst = WS_WO0; }
        else if ((r -= I1) < I1) { W = args.in[5]; ldw = D; K = D; nblk = 32; dst = WS_WQKV1; mode = 1; }
        else if ((r -= I1) < I1) { W = args.in[4]; ldw = 2 * D; K = D; nblk = 32; dst = WS_WQKV1; mode = 1; off = D; }
        else if ((r -= I1) < I1) { W = args.in[4] + D; ldw = 2 * D; K = D; nblk = 32; dst = WS_WQKV1; off = 2 * D; }
        else if ((r -= I1) < I1) { W = args.in[8]; ldw = D; K = D; nblk = 32; dst = WS_WO1; }
        else if ((r -= I1) < I7) { W = args.in[9]; ldw = FF2; K = D; nblk = 176; dst = WS_WIN0; mode = 2; }
        else if ((r -= I7) < I7) { W = args.in[9] + (size_t)D * FF2; ldw = FF2; K = D; nblk = 176; dst = WS_WIN1; mode = 2; }
        else if ((r -= I7) < I9) { W = args.in[12]; ldw = D; K = FF; nblk = 32; dst = WS_WOUT0; }
        else { r -= I9; W = args.in[12] + (size_t)FF * D; ldw = D; K = FF; nblk = 32; dst = WS_WOUT1; }
        p0_transpose_item(W, ldw, K, nblk, (bf16*)(ws + dst), mode, off, scr, r, F.lane);
    }
    {
        float* cosT = (float*)(ws + WS_COS); float* sinT = (float*)(ws + WS_SIN);
        for (int e = (int)blockIdx.x * (NWAVES * 64) + F.tid; e < SEQ * 32; e += F.G * NWAVES * 64) {
            const int pos = e >> 5, i = e & 31;
            double invd = 1.0; for (int q_ = 0; q_ < i; ++q_) invd *= 0.7498942093324559;
            const float inv = (float)invd;
            const float ang = (float)pos * inv;
            double s, c; sincos_d((double)ang, s, c);
            cosT[e] = (float)c; sinT[e] = (float)s;
        }
    }
    __syncthreads();
    {
        LAS float* wf = (LAS float*)(F.lds + RING_OFF);
        const float* Win = args.in[1];
        for (int e = F.tid; e < 16 * D; e += NWAVES * 64) { const int k = e >> 4, h = e & 15; wf[h * D + k] = Win[(size_t)k * AWIN_LD + 3 * D + h]; }
        __syncthreads();
        const float* x = args.in[0]; bf16* XB = (bf16*)(ws + WS_XB); float* flog = (float*)(ws + WS_FLOG); const float* bfv = args.in[2];
        for (int m = gw; m < M; m += NGW) {
            const GAS f32x4* xr = (const GAS f32x4*)(x + (size_t)m * D) + F.lane;
            f32x4 v[4];
#pragma unroll
            for (int j = 0; j < 4; ++j) v[j] = xr[64 * j];
            GAS unsigned long long* o8 = (GAS unsigned long long*)(XB + (size_t)m * D) + F.lane;
#pragma unroll
            for (int j = 0; j < 4; ++j) o8[64 * j] = (unsigned long long)pk2(v[j].x, v[j].y) | ((unsigned long long)pk2(v[j].z, v[j].w) << 32);
            float mine = 0.f;
#pragma unroll 2
            for (int h = 0; h < 16; ++h) {
                float a = 0.f;
#pragma unroll
                for (int j = 0; j < 4; ++j) { const f32x4 w = *(const LAS f32x4*)(wf + h * D + 256 * j + 4 * F.lane); a += (v[j].x * w.x + v[j].y * w.y) + (v[j].z * w.z + v[j].w * w.w); }
                a = wave_sum(a);
                if (F.lane == h) mine = a;
            }
            if (F.lane < 16) flog[(size_t)m * 16 + F.lane] = mine + bfv[F.lane];
        }
    }
    __syncthreads();
}

__device__ __forceinline__ void scan_phase(Frame& F, const Args& args) {
    if (blockIdx.x >= BATCH * NH) return;
    const int bh = blockIdx.x, b = bh >> 4, h = bh & 15;
    const float* flog = (const float*)(args.ws + WS_FLOG); double* ck = (double*)(args.ws + WS_CK) + (size_t)bh * SEQ;
    LAS double* wtot = (LAS double*)(F.lds + RING_OFF);
    double loc[8]; double run = 0.0;
#pragma unroll
    for (int e = 0; e < 8; ++e) {
        const float f = flog[(size_t)(b * SEQ + F.tid * 8 + e) * 16 + h];
        const float ls = fminf(f, 0.f) - log1pf(expf(-fabsf(f)));
        run += (double)ls * 1.4426950408889634; loc[e] = run;
    }
    double inc = run;
#pragma unroll
    for (int o = 1; o < 64; o <<= 1) { const double t = __shfl_up(inc, o); if (F.lane >= o) inc += t; }
    if (F.lane == 63) wtot[F.wave] = inc;
    __syncthreads();
    double base = inc - run;
    for (int w = 0; w < F.wave; ++w) base += wtot[w];
    v4u* bt = (v4u*)(args.ws + WS_BT) + ((size_t)bh * SEQ + F.tid * 8) * 2;
#pragma unroll
    for (int e = 0; e < 8; ++e) {
        const double v = -(base + loc[e]);
        ck[F.tid * 8 + e] = base + loc[e];
        const unsigned hi = f2bf((float)v); const double r1 = v - (double)__uint_as_float(hi << 16);
        const unsigned mid = f2bf((float)r1); const double r2 = r1 - (double)__uint_as_float(mid << 16);
        const unsigned lo = f2bf((float)r2);
        bt[2 * e] = (v4u){hi | (mid << 16), lo | 0x3F800000u, 0x3F803F80u, 0u}; bt[2 * e + 1] = (v4u){0u, 0u, 0u, 0u};
    }
    __syncthreads();
}

__device__ __forceinline__ void ln_phase(Frame& F, const float* xin, const float* hs, const float* g, const float* bta, float* xout, bf16* xb, int row0, int nrows) {
    const int gw = F.vcu * NWAVES + F.wave, NGW = F.G * NWAVES;
    for (int r = gw; r < nrows; r += NGW) {
        const int m = row0 + r;
        const GAS f32x4* xr = (const GAS f32x4*)(xin + (size_t)m * D) + F.lane;
        const GAS f32x4* hr = (const GAS f32x4*)(hs + (size_t)r * D) + F.lane;
        f32x4 v[4]; float s = 0.f;
#pragma unroll
        for (int j = 0; j < 4; ++j) { v[j] = xr[64 * j] * DN_ALPHA + hr[64 * j]; s += (v[j].x + v[j].y) + (v[j].z + v[j].w); }
        const float mean = wave_sum(s) * (1.f / D); float s2 = 0.f;
#pragma unroll
        for (int j = 0; j < 4; ++j) { v[j] = v[j] - mean; s2 += (v[j].x * v[j].x + v[j].y * v[j].y) + (v[j].z * v[j].z + v[j].w * v[j].w); }
        const float rstd = 1.f / sqrtf(wave_sum(s2) * (1.f / D) + LN_EPS);
        GAS f32x4* xo = (GAS f32x4*)(xout + (size_t)m * D) + F.lane;
        GAS unsigned long long* o8 = (GAS unsigned long long*)(xb + (size_t)m * D) + F.lane;
#pragma unroll
        for (int j = 0; j < 4; ++j) {
            const f32x4 gg = *((const GAS f32x4*)g + F.lane + 64 * j), bb = *((const GAS f32x4*)bta + F.lane + 64 * j);
            const f32x4 y = v[j] * rstd * gg + bb;
            xo[64 * j] = y;
            o8[64 * j] = (unsigned long long)pk2(y.x, y.y) | ((unsigned long long)pk2(y.z, y.w) << 32);
        }
    }
}

__device__ __forceinline__ void conv_gate_phase(Frame& F, const bf16* U, const float* cw, const float* cb, bf16* Hh, int row0, int nrows) {
    const int NCH = FF / 8;
    const long total = (long)nrows * NCH;
    for (long it = (long)blockIdx.x * (NWAVES * 64) + F.tid; it < total; it += (long)F.G * NWAVES * 64) {
        const int lr = (int)(it / NCH), c8 = (int)(it % NCH), c = c8 * 8;
        const int s = (row0 + lr) % SEQ;
        const int ug = 256 * (c >> 7) + (c & 127), uv = ug + 128;
        float g[8], vv[8];
#pragma unroll
        for (int e = 0; e < 8; ++e) { g[e] = cb[c + e]; vv[e] = cb[FF + c + e]; }
#pragma unroll
        for (int j = 0; j < 3; ++j) {
            const int back = 2 - j;
            if (s >= back) {
                const bf16x8 a = *(const GAS bf16x8*)(U + (size_t)(lr - back) * FF2 + ug);
                const bf16x8 bq = *(const GAS bf16x8*)(U + (size_t)(lr - back) * FF2 + uv);
#pragma unroll
                for (int e = 0; e < 8; ++e) { g[e] += cw[j * FF2 + c + e] * bf2f((unsigned short)a[e]); vv[e] += cw[j * FF2 + FF + c + e] * bf2f((unsigned short)bq[e]); }
            }
        }
        v4u o; float r[8];
#pragma unroll
        for (int e = 0; e < 8; ++e) r[e] = g[e] / (1.f + expf(-g[e])) * vv[e];
        o.x = pk2(r[0], r[1]); o.y = pk2(r[2], r[3]); o.z = pk2(r[4], r[5]); o.w = pk2(r[6], r[7]);
        *(GAS v4u*)(Hh + (size_t)lr * FF + c) = o;
    }
}

__device__ __forceinline__ void rope_phase(Frame& F, bf16* Q1, bf16* K12, const float* cosT, const float* sinT) {
    const long total = (long)M * 256;
    for (long it = (long)blockIdx.x * (NWAVES * 64) + F.tid; it < total; it += (long)F.G * NWAVES * 64) {
        const int t = (int)(it >> 8), w = (int)(it & 255), ch = w & 127; bf16* buf = (w >> 7) ? K12 : Q1;
        const int a = ch & 7, s = t % SEQ;
        bf16* p = buf + (size_t)t * D + ch * 8;
        const bf16x8 v = *(const GAS bf16x8*)p;
        const f32x4 cs = *(const GAS f32x4*)(cosT + s * 32 + 4 * a), sn = *(const GAS f32x4*)(sinT + s * 32 + 4 * a);
        float o[8];
#pragma unroll
        for (int e = 0; e < 4; ++e) { const float t1 = bf2f((unsigned short)v[e]), t2 = bf2f((unsigned short)v[4 + e]); o[e] = t1 * cs[e] - t2 * sn[e]; o[4 + e] = t2 * cs[e] + t1 * sn[e]; }
        v4u ov; ov.x = pk2(o[0], o[1]); ov.y = pk2(o[2], o[3]); ov.z = pk2(o[4], o[5]); ov.w = pk2(o[6], o[7]);
        *(GAS v4u*)p = ov;
    }
}

__device__ __forceinline__ void attn_fox_simple(Frame& F, const bf16* Q, const bf16* K, const bf16* V, bf16* O, const double* ck) {
    LAS float* Ks = (LAS float*)(F.lds + RING_OFF);
    LAS float* Vs = (LAS float*)(F.lds + RING_OFF + 16384);
    LAS double* cks = (LAS double*)(F.lds + RING_OFF + 32768);
    const int bh = (int)blockIdx.x >> 2, jj = (int)blockIdx.x & 3, b = bh >> 4, h = bh & 15;
    for (int ui = 0; ui < 2; ++ui) {
        const int rb = ui == 0 ? jj : 7 - jj, q0 = rb * 512, row = q0 + F.tid;
        const size_t t = (size_t)b * SEQ + row;
        float q[64];
#pragma unroll
        for (int c = 0; c < 8; ++c) { const bf16x8 v = *(const GAS bf16x8*)(Q + t * D + h * 64 + c * 8);
#pragma unroll
            for (int e = 0; e < 8; ++e) q[c * 8 + e] = bf2f((unsigned short)v[e]); }
        const double cq = ck[(size_t)bh * SEQ + row];
        float o[64];
#pragma unroll
        for (int d = 0; d < 64; ++d) o[d] = 0.f;
        float mrun = -INFINITY, l = 0.f;
        const int nkt = (q0 + 512) / 64;
        for (int kt = 0; kt < nkt; ++kt) {
            __syncthreads();
            { const int r = F.tid >> 3, c = F.tid & 7; const size_t kr = ((size_t)b * SEQ + kt * 64 + r) * D + h * 64 + c * 8;
              const bf16x8 kv = *(const GAS bf16x8*)(K + kr); const bf16x8 vv = *(const GAS bf16x8*)(V + kr);
#pragma unroll
              for (int e = 0; e < 8; ++e) { Ks[r * 64 + c * 8 + e] = bf2f((unsigned short)kv[e]); Vs[r * 64 + c * 8 + e] = bf2f((unsigned short)vv[e]); }
              if (F.tid < 64) cks[F.tid] = ck[(size_t)bh * SEQ + kt * 64 + F.tid]; }
            __syncthreads();
            if (kt * 64 <= row) {
                for (int j = 0; j < 64; ++j) {
                    float s = 0.f;
#pragma unroll
                    for (int d = 0; d < 64; d += 4) { const f32x4 kk = *(const LAS f32x4*)(Ks + j * 64 + d); s += (q[d] * kk.x + q[d + 1] * kk.y) + (q[d + 2] * kk.z + q[d + 3] * kk.w); }
                    s += (float)(cq - cks[j]);
                    if (kt * 64 + j > row) s = -INFINITY;
                    if (s > mrun) { const float sc = exp2f(mrun - s); l *= sc;
#pragma unroll
                        for (int d = 0; d < 64; ++d) o[d] *= sc;
                        mrun = s; }
                    const float p = exp2f(s - mrun); l += p;
#pragma unroll
                    for (int d = 0; d < 64; d += 4) { const f32x4 vv = *(const LAS f32x4*)(Vs + j * 64 + d); o[d] += p * vv.x; o[d + 1] += p * vv.y; o[d + 2] += p * vv.z; o[d + 3] += p * vv.w; }
                }
            }
        }
        const float inv = 1.f / l;
#pragma unroll
        for (int c = 0; c < 8; ++c) { v4u w; w.x = pk2(o[c * 8] * inv, o[c * 8 + 1] * inv); w.y = pk2(o[c * 8 + 2] * inv, o[c * 8 + 3] * inv); w.z = pk2(o[c * 8 + 4] * inv, o[c * 8 + 5] * inv); w.w = pk2(o[c * 8 + 6] * inv, o[c * 8 + 7] * inv);
            *(GAS v4u*)(O + t * D + h * 64 + c * 8) = w; }
    }
    __syncthreads();
}
__device__ __forceinline__ void attn_diff_simple(Frame& F, const bf16* Q1, const bf16* K12, const bf16* V, bf16* O, float* S1, const float* lamp, const float* subg) {
    LAS float* Ks = (LAS float*)(F.lds + RING_OFF);
    LAS float* Vs = (LAS float*)(F.lds + RING_OFF + 16384);
    float s01 = 0.f, s23 = 0.f;
    for (int e = 0; e < 64; ++e) { s01 += lamp[e] * lamp[64 + e]; s23 += lamp[128 + e] * lamp[192 + e]; }
    const float lam = expf(s01) - expf(s23) + LAMBDA_INIT;
    const int bh = (int)blockIdx.x >> 3, jj = (int)blockIdx.x & 7, b = bh >> 3, h = bh & 7;
    const int half = F.tid & 1;
    for (int ui = 0; ui < 2; ++ui) {
        const int rb = ui == 0 ? jj : 15 - jj, q0 = rb * 256, row = q0 + (F.tid >> 1);
        const size_t t = (size_t)b * SEQ + row;
        const int nkt = (q0 + 256) / 64;
        for (int i = 0; i < 2; ++i) {
            float q[64];
#pragma unroll
            for (int c = 0; c < 8; ++c) { const bf16x8 v = *(const GAS bf16x8*)(Q1 + t * D + i * 512 + h * 64 + c * 8);
#pragma unroll
                for (int e = 0; e < 8; ++e) q[c * 8 + e] = bf2f((unsigned short)v[e]); }
            float o[64];
#pragma unroll
            for (int d = 0; d < 64; ++d) o[d] = 0.f;
            float mrun = -INFINITY, l = 0.f;
            for (int kt = 0; kt < nkt; ++kt) {
                __syncthreads();
                { const int r = F.tid >> 3, c = F.tid & 7; const size_t rowk = (size_t)b * SEQ + kt * 64 + r;
                  const bf16x8 kv = *(const GAS bf16x8*)(K12 + rowk * D + i * 512 + h * 64 + c * 8);
                  const bf16x8 v0 = *(const GAS bf16x8*)(V + rowk * D + h * 128 + c * 16); const bf16x8 v1 = *(const GAS bf16x8*)(V + rowk * D + h * 128 + c * 16 + 8);
#pragma unroll
                  for (int e = 0; e < 8; ++e) { Ks[r * 64 + c * 8 + e] = bf2f((unsigned short)kv[e]); Vs[r * 128 + c * 16 + e] = bf2f((unsigned short)v0[e]); Vs[r * 128 + c * 16 + 8 + e] = bf2f((unsigned short)v1[e]); } }
                __syncthreads();
                if (kt <= (row >> 6)) {
                    for (int j = 0; j < 64; ++j) {
                        float s = 0.f;
#pragma unroll
                        for (int d = 0; d < 64; d += 4) { const f32x4 kk = *(const LAS f32x4*)(Ks + j * 64 + d); s += (q[d] * kk.x + q[d + 1] * kk.y) + (q[d + 2] * kk.z + q[d + 3] * kk.w); }
                        if (s > mrun) { const float sc = exp2f(mrun - s); l *= sc;
#pragma unroll
                            for (int d = 0; d < 64; ++d) o[d] *= sc;
                            mrun = s; }
                        const float p = exp2f(s - mrun); l += p;
#pragma unroll
                        for (int d = 0; d < 64; d += 4) { const f32x4 vv = *(const LAS f32x4*)(Vs + j * 128 + half * 64 + d); o[d] += p * vv.x; o[d + 1] += p * vv.y; o[d + 2] += p * vv.z; o[d + 3] += p * vv.w; }
                    }
                }
            }
            const float inv = 1.f / l;
            float* sp = S1 + t * D + h * 128 + half * 64;
            if (i == 0) {
#pragma unroll
                for (int d = 0; d < 64; d += 4) *(GAS f32x4*)(sp + d) = (f32x4){o[d] * inv, o[d + 1] * inv, o[d + 2] * inv, o[d + 3] * inv};
            } else {
                float ss = 0.f;
#pragma unroll
                for (int d = 0; d < 64; d += 4) { const f32x4 a = *(const GAS f32x4*)(sp + d);
                    o[d] = a.x - lam * (o[d] * inv); o[d + 1] = a.y - lam * (o[d + 1] * inv); o[d + 2] = a.z - lam * (o[d + 2] * inv); o[d + 3] = a.w - lam * (o[d + 3] * inv);
                    ss += (o[d] * o[d] + o[d + 1] * o[d + 1]) + (o[d + 2] * o[d + 2] + o[d + 3] * o[d + 3]); }
                ss += __shfl_xor(ss, 1);
                const float rr = 1.f / sqrtf(ss * (1.f / 128.f) + RMS_EPS) * (1.f - LAMBDA_INIT);
#pragma unroll
                for (int c = 0; c < 8; ++c) { float y[8];
#pragma unroll
                    for (int e = 0; e < 8; ++e) y[e] = o[c * 8 + e] * rr * subg[half * 64 + c * 8 + e];
                    v4u w; w.x = pk2(y[0], y[1]); w.y = pk2(y[2], y[3]); w.z = pk2(y[4], y[5]); w.w = pk2(y[6], y[7]);
                    *(GAS v4u*)(O + t * D + h * 128 + half * 64 + c * 8) = w; }
            }
        }
    }
    __syncthreads();
}

__device__ __forceinline__ void rms_phase(Frame& F, const float* S, const float* subg, bf16* Ob) {
    const int gw = F.vcu * NWAVES + F.wave, NGW = F.G * NWAVES;
    const f32x4 gg = *((const GAS f32x4*)subg + (F.lane & 31));
    for (int m = gw; m < M; m += NGW) {
        const GAS f32x4* sr = (const GAS f32x4*)(S + (size_t)m * D) + F.lane;
        GAS unsigned long long* o8 = (GAS unsigned long long*)(Ob + (size_t)m * D) + F.lane;
#pragma unroll
        for (int j = 0; j < 4; ++j) {
            const f32x4 v = sr[64 * j];
            float ss = (v.x * v.x + v.y * v.y) + (v.z * v.z + v.w * v.w);
#pragma unroll
            for (int o = 1; o < 32; o <<= 1) ss += __shfl_xor(ss, o);
            const float rr = 1.f / sqrtf(ss * (1.f / 128.f) + RMS_EPS) * (1.f - LAMBDA_INIT);
            const f32x4 y = v * rr * gg;
            o8[64 * j] = (unsigned long long)pk2(y.x, y.y) | ((unsigned long long)pk2(y.z, y.w) << 32);
        }
    }
}

#define RELAUNDER() do { int t_ = threadIdx.x; asm volatile("" : "+v"(t_)); F.tid = t_; F.lane = t_ & 63; F.wave = __builtin_amdgcn_readfirstlane(t_ >> 6); } while (0)
__global__ void __launch_bounds__(NWAVES * 64, 2) yoco_fwd(Args args) {
    extern __shared__ __attribute__((aligned(16))) unsigned char lds[];
    Frame F;
    F.lds = (LAS unsigned char*)lds;
    F.MISC = (volatile LAS unsigned*)(F.lds + MISC_OFF);
    F.tid = threadIdx.x; F.lane = F.tid & 63; F.wave = __builtin_amdgcn_readfirstlane(F.tid >> 6);
    F.G = gridDim.x; { const int bx = blockIdx.x; F.vcu = (F.G % 8 == 0) ? (bx % 8) * (F.G / 8) + bx / 8 : bx; }
    unsigned char* ws = args.ws;
    F.ctl = (gu32*)(ws + WS_CTL);
    for (int u = F.tid; u < (EX_OFF - LDSCTL_OFF) / 4; u += NWAVES * 64) ((LAS unsigned*)(F.lds + LDSCTL_OFF))[u] = 0u;
    __syncthreads();
    XcdBarrier bar = xcd_barrier_post((unsigned*)(F.ctl + CW_BAR), F.MISC + 8);

    p0_prologue(F, args);
    xcd_barrier(bar);

    for (int layer = 0; layer < 2; ++layer) {
        bf16* XB = (bf16*)(ws + WS_XB); bf16* QO = (bf16*)(ws + WS_QO); bf16* KB = (bf16*)(ws + WS_KB); bf16* VB = (bf16*)(ws + WS_VB);
        float* HS = (float*)(ws + WS_HS); bf16* HB = (bf16*)(ws + WS_HB);
        RELAUNDER();
        if (layer == 0) scan_phase(F, args);
        {
            pg8::Gemm g{XB, (const bf16*)(ws + (layer ? WS_WQKV1 : WS_WQKV0)), M, 3 * D, D};
            pg8::StaticOrder S; S.init(g.M, g.N, F.G, (int)blockIdx.x);
            pg8::EpiBf16<0> E{QO, D, nullptr, D, (size_t)(WS_KB - WS_QO) / 2, C2};
            pg8::gemm_phase<pg8::EpiBf16<0>, pg8::StaticOrder, PG8_ALIGN, PG8_SP2>(F.lds + RING_OFF, g, S, E);
        }
        xcd_barrier(bar);
        RELAUNDER();
        if (layer == 0) {
            const attn_body::AttnTensors AT{(const attn_body::bf16*)QO, (const attn_body::bf16*)KB, (const attn_body::bf16*)VB, (attn_body::bf16*)QO};
            const attn_body::StaticOrder S((int)F.G, (int)blockIdx.x);
            attn_body::attn_phase<attn_body::StaticOrder, 8, true>((char*)lds + RING_OFF, AT, S, ws + WS_BT);
        } else {
            rope_phase(F, QO, KB, (const float*)(ws + WS_COS), (const float*)(ws + WS_SIN));
            xcd_barrier(bar);
            const float* lamp = args.in[6]; float s01 = 0.f, s23 = 0.f;
            for (int e = 0; e < 64; ++e) { s01 += lamp[e] * lamp[64 + e]; s23 += lamp[128 + e] * lamp[192 + e]; }
            const float lam = expf(s01) - expf(s23) + LAMBDA_INIT;
            attn_body::diff_phase<8>((char*)lds + RING_OFF, (const attn_body::bf16*)QO, (const attn_body::bf16*)KB, (const attn_body::bf16*)VB, HS, lam, (int)F.G, (int)blockIdx.x);
            xcd_barrier(bar);
            RELAUNDER();
            rms_phase(F, HS, args.in[7], XB);
        }
        xcd_barrier(bar);
        {
            pg8::Gemm g{layer ? XB : QO, (const bf16*)(ws + (layer ? WS_WO1 : WS_WO0)), M, D, D};
            pg8::StaticOrder S; S.init(g.M, g.N, F.G, (int)blockIdx.x);
            pg8::EpiF32 E{HS, D};
            pg8::gemm_phase<pg8::EpiF32, pg8::StaticOrder, PG8_ALIGN, PG8_SP2>(F.lds + RING_OFF, g, S, E);
        }
        xcd_barrier(bar);
        RELAUNDER();
        ln_phase(F, layer ? args.out : args.in[0], HS, args.in[13] + (size_t)layer * D, args.in[14] + (size_t)layer * D, args.out, XB, 0, M);
        xcd_barrier(bar);
        {
            pg8::Gemm g{XB, (const bf16*)(ws + (layer ? WS_WIN1 : WS_WIN0)), pg8::EpiConvGate::TPB * BATCH * 256, FF2, D};
            pg8::StaticOrder S; S.init(g.M, g.N, F.G, (int)blockIdx.x);
            pg8::EpiConvGate E{HB, args.in[10] + (size_t)layer * 3 * FF2, args.in[11] + (size_t)layer * FF2, (LAS float*)(F.lds + EX_OFF)};
            pg8::gemm_phase<pg8::EpiConvGate, pg8::StaticOrder, true, PG8_SP2>(F.lds + RING_OFF, g, S, E);
        }
        xcd_barrier(bar);
        {
            pg8::Gemm g{HB, (const bf16*)(ws + (layer ? WS_WOUT1 : WS_WOUT0)), M, D, FF};
            pg8::StaticOrder S; S.init(g.M, g.N, F.G, (int)blockIdx.x);
            pg8::EpiF32 E{HS, D};
            pg8::gemm_phase<pg8::EpiF32, pg8::StaticOrder, PG8_ALIGN, PG8_SP2>(F.lds + RING_OFF, g, S, E);
        }
        xcd_barrier(bar);
        RELAUNDER();
        ln_phase(F, args.out, HS, args.in[15] + (size_t)layer * D, args.in[16] + (size_t)layer * D, args.out, XB, 0, M);
        if (layer == 0) xcd_barrier(bar);
    }
}

extern "C" void kernel_launch(void* const* d_in, const int* in_sizes, int n_in, void* d_out, int out_size, void* d_ws, size_t ws_size, hipStream_t stream) {
    static int grid = 0;
    if (grid == 0) {
        if (n_in != 17 || out_size != M * D || ws_size < WS_END) { fprintf(stderr, "kernel_launch: unexpected shapes (n_in %d out %d ws %zu)\n", n_in, out_size, ws_size); grid = -1; return; }
        int dev = 0, cus = 0;
        if (hipGetDevice(&dev) != hipSuccess || hipDeviceGetAttribute(&cus, hipDeviceAttributeMultiprocessorCount, dev) != hipSuccess) { grid = -1; return; }
        if (hipFuncSetAttribute((const void*)yoco_fwd, hipFuncAttributeMaxDynamicSharedMemorySize, LDS_BYTES) != hipSuccess) { fprintf(stderr, "kernel_launch: hipFuncSetAttribute failed\n"); grid = -1; return; }
        (void)hipGetLastError();
        grid = cus;
        if (grid != 256) fprintf(stderr, "kernel_launch: %d CUs; this build expects 256\n", grid);
    }
    if (grid < 0) return;
    (void)hipMemsetAsync((char*)d_ws + WS_CTL, 0, CTL_ZERO_BYTES, stream);
    Args a{};
    for (int i = 0; i < 17; ++i) a.in[i] = (const float*)d_in[i];
    a.out = (float*)d_out; a.ws = (unsigned char*)d_ws;
    hipLaunchKernelGGL(yoco_fwd, dim3(grid), dim3(NWAVES * 64), LDS_BYTES, stream, a);
}
```
